# Optimizing an MI355X kernel written in HIP

```python
import math
import jax, jax.numpy as jnp
from jax import lax
import numpy as np

D_MODEL = 4096
BATCH = 4
SEQ = 4096
DEPTH = 2

D_FF = ((8 * D_MODEL // 3 + 255) // 256) * 256
SSM_WIDTH = D_MODEL // 4
SSM_GROUP = 16
SSM_GROUPS = SSM_WIDTH // SSM_GROUP
SSM_STATE = 64
RET_WIDTH = 3 * D_MODEL // 8
RET_KEY_DIM = 128
RET_VAL_DIM = 2 * RET_KEY_DIM
RET_HEADS = RET_WIDTH // RET_VAL_DIM
RET_CHUNK = 128
DIFF_WIDTH = 3 * D_MODEL // 8
DIFF_HEAD_DIM = 64
DIFF_VAL_DIM = 2 * DIFF_HEAD_DIM
DIFF_HEADS = DIFF_WIDTH // DIFF_VAL_DIM
Q_BLOCK = 128
N_BRANCH = 3
NORM_EPS = 1e-6
IN_SIZES = (SSM_WIDTH, RET_HEADS * RET_KEY_DIM, RET_HEADS * RET_KEY_DIM, RET_WIDTH, RET_WIDTH,
            DIFF_HEADS * 2 * DIFF_HEAD_DIM, DIFF_HEADS * 2 * DIFF_HEAD_DIM, DIFF_WIDTH, N_BRANCH * D_MODEL)
N_IN = sum(IN_SIZES)

kernel_name = "hybrid_s5_retention_diffattn_macaron"


def _split_points():
    pts, acc = [], 0
    for s in IN_SIZES[:-1]:
        acc += s
        pts.append(acc)
    return pts


def _rms(x):
    xf = x.astype(jnp.float32)
    return xf * lax.rsqrt(jnp.mean(xf * xf, axis=-1, keepdims=True) + NORM_EPS)


def rms_norm(x, gain):
    return (_rms(x) * gain.astype(jnp.float32)).astype(x.dtype)


def swiglu(x, w_in, w_out):
    gate, up = jnp.split(x @ w_in, 2, axis=-1)
    return (jax.nn.silu(gate) * up) @ w_out


def alibi_slopes(n_heads):
    return jnp.asarray(2.0 ** (-8.0 * np.arange(1, n_heads + 1) / n_heads), dtype=jnp.float32)


def s5_branch(u, lam_re, lam_im, log_dt, b_re, b_im, c_re, c_im, d_skip, glu_w, glu_b):
    f32 = jnp.float32
    bsz, seq, _ = u.shape
    ug = u.reshape(bsz, seq, SSM_GROUPS, SSM_GROUP).astype(f32)
    dt = jnp.exp(log_dt.astype(f32))[:, None]
    lr, li = lam_re.astype(f32), lam_im.astype(f32)
    mag = jnp.exp(lr * dt)
    ab_re, ab_im = mag * jnp.cos(li * dt), mag * jnp.sin(li * dt)
    den = lr * lr + li * li
    nr, ni = ab_re - 1.0, ab_im
    coef_re = (nr * lr + ni * li) / den
    coef_im = (ni * lr - nr * li) / den
    br, bi = b_re.astype(f32), b_im.astype(f32)
    bb_re = coef_re[..., None] * br - coef_im[..., None] * bi
    bb_im = coef_re[..., None] * bi + coef_im[..., None] * br
    bu_re = jnp.einsum('blgc,gpc->blgp', ug, bb_re)
    bu_im = jnp.einsum('blgc,gpc->blgp', ug, bb_im)
    a_re = jnp.broadcast_to(ab_re, (1, seq) + ab_re.shape)
    a_im = jnp.broadcast_to(ab_im, (1, seq) + ab_im.shape)

    def combine(e1, e2):
        a1r, a1i, b1r, b1i = e1
        a2r, a2i, b2r, b2i = e2
        return (a2r * a1r - a2i * a1i,
                a2r * a1i + a2i * a1r,
                a2r * b1r - a2i * b1i + b2r,
                a2r * b1i + a2i * b1r + b2i)

    _, _, xr, xi = lax.associative_scan(combine, (a_re, a_im, bu_re, bu_im), axis=1)
    y = (jnp.einsum('blgp,gcp->blgc', xr, c_re.astype(f32))
         - jnp.einsum('blgp,gcp->blgc', xi, c_im.astype(f32))
         + d_skip.astype(f32) * ug)
    y = jax.nn.gelu(y.reshape(bsz, seq, SSM_WIDTH).astype(u.dtype))
    return y * jax.nn.sigmoid(y @ glu_w + glu_b)


def retention_branch(q, k, v, g):
    bsz, seq = q.shape[0], q.shape[1]
    nc, c = seq // RET_CHUNK, RET_CHUNK
    dt = q.dtype
    log_gamma = jnp.asarray(np.log(1.0 - 2.0 ** (-5.0 - np.arange(RET_HEADS))), jnp.float32)
    pos = jnp.arange(c, dtype=jnp.float32)
    rel = pos[:, None] - pos[None, :]
    intra_decay = jnp.where(rel >= 0, jnp.exp(log_gamma[:, None, None] * jnp.maximum(rel, 0.0)), 0.0).astype(dt)
    key_decay = jnp.exp(log_gamma[:, None] * (c - 1 - pos)).astype(dt)
    query_decay = jnp.exp(log_gamma[:, None] * (pos + 1)).astype(dt)
    chunk_decay = jnp.exp(log_gamma * c).astype(dt)
    qc = q.reshape(bsz, nc, c, RET_HEADS, RET_KEY_DIM)
    kc = k.reshape(bsz, nc, c, RET_HEADS, RET_KEY_DIM) * (RET_KEY_DIM ** -0.5)
    vc = v.reshape(bsz, nc, c, RET_HEADS, RET_VAL_DIM)
    scores = jnp.einsum('bnchd,bnmhd->bnhcm', qc, kc) * intra_decay
    intra = jnp.einsum('bnhcm,bnmhe->bnche', scores, vc)
    kv = jnp.einsum('bnmhd,hm,bnmhe->nbhde', kc, key_decay, vc)

    def step(state, kv_chunk):
        return chunk_decay[None, :, None, None] * state + kv_chunk, state

    _, prev = lax.scan(step, jnp.zeros(kv.shape[1:], kv.dtype), kv)
    inter = jnp.einsum('bnchd,hc,nbhde->bnche', qc, query_decay, prev)
    o = _rms(intra + inter).astype(dt).reshape(bsz, seq, RET_WIDTH)
    return jax.nn.silu(g) * o


def diff_attention_branch(q, k, v, q_gain, k_gain, lq1, lk1, lq2, lk2, sub_gain, lambda_init):
    f32 = jnp.float32
    bsz, seq = q.shape[0], q.shape[1]
    nb = seq // Q_BLOCK
    q = rms_norm(q, q_gain) * (DIFF_HEAD_DIM ** -0.5)
    k = rms_norm(k, k_gain)
    lam = (jnp.exp(jnp.sum(lq1.astype(f32) * lk1.astype(f32)))
           - jnp.exp(jnp.sum(lq2.astype(f32) * lk2.astype(f32))) + lambda_init)
    q_blocks = q.reshape(bsz, nb, Q_BLOCK, DIFF_HEADS, 2, DIFF_HEAD_DIM).transpose(1, 0, 3, 4, 2, 5)
    k_t = k.transpose(0, 2, 3, 1, 4)
    v_t = v.reshape(bsz, seq, DIFF_HEADS, DIFF_VAL_DIM).transpose(0, 2, 1, 3)
    slopes = alibi_slopes(DIFF_HEADS)[:, None, None, None]
    key_pos = jnp.arange(seq)

    def attend(args):
        q_blk, start = args
        dist = ((start + jnp.arange(Q_BLOCK))[:, None] - key_pos[None, :]).astype(f32)
        s = jnp.einsum('bhiqd,bhisd->bhiqs', q_blk, k_t).astype(f32) - slopes * dist
        s = jnp.where(dist >= 0, s, -jnp.inf)
        p = jax.nn.softmax(s, axis=-1)
        w = (p[:, :, 0] - lam * p[:, :, 1]).astype(v_t.dtype)
        return jnp.einsum('bhqs,bhse->bqhe', w, v_t)

    out = lax.map(attend, (q_blocks, jnp.arange(nb) * Q_BLOCK))
    out = out.transpose(1, 0, 2, 3, 4).reshape(bsz, seq, DIFF_HEADS, DIFF_VAL_DIM)
    out = rms_norm(out, sub_gain) * (1.0 - lambda_init)
    return out.reshape(bsz, seq, DIFF_WIDTH)


def setup_inputs(seed: int = 0) -> dict:
    key = jax.random.key(seed)
    ks = jax.random.split(key, 26)
    f32 = jnp.float32
    L, G, P, C = DEPTH, SSM_GROUPS, SSM_STATE, SSM_GROUP

    def nrm(k, shape, scale):
        return jax.random.normal(k, shape, f32) * scale

    return {
        "x": jax.random.normal(ks[0], (BATCH, SEQ, D_MODEL), f32),
        "norm_w": 1.0 + nrm(ks[1], (L, 3, D_MODEL), 0.01),
        "ffn_w_in": nrm(ks[2], (L, 2, D_MODEL, 2 * D_FF), D_MODEL ** -0.5),
        "ffn_w_out": nrm(ks[3], (L, 2, D_FF, D_MODEL), D_FF ** -0.5),
        "mix_w_in": nrm(ks[4], (L, D_MODEL, N_IN), D_MODEL ** -0.5),
        "ssm_lambda_re": -0.5 + nrm(ks[5], (L, G, P), 0.01),
        "ssm_lambda_im": math.pi * jnp.arange(P, dtype=f32) + nrm(ks[6], (L, G, P), 0.01),
        "ssm_log_dt": jax.random.uniform(ks[7], (L, G), f32, math.log(1e-3), math.log(1e-1)),
        "ssm_b_re": nrm(ks[8], (L, G, P, C), (2 * C) ** -0.5),
        "ssm_b_im": nrm(ks[9], (L, G, P, C), (2 * C) ** -0.5),
        "ssm_c_re": nrm(ks[10], (L, G, C, P), (2 * P) ** -0.5),
        "ssm_c_im": nrm(ks[11], (L, G, C, P), (2 * P) ** -0.5),
        "ssm_d": nrm(ks[12], (L, G, C), 1.0),
        "ssm_glu_w": nrm(ks[13], (L, SSM_WIDTH, SSM_WIDTH), SSM_WIDTH ** -0.5),
        "ssm_glu_b": nrm(ks[14], (L, SSM_WIDTH), 0.01),
        "diff_q_gain": 1.0 + nrm(ks[15], (L, DIFF_HEAD_DIM), 0.01),
        "diff_k_gain": 1.0 + nrm(ks[16], (L, DIFF_HEAD_DIM), 0.01),
        "diff_lambda_q1": nrm(ks[17], (L, DIFF_HEAD_DIM), 0.1),
        "diff_lambda_k1": nrm(ks[18], (L, DIFF_HEAD_DIM), 0.1),
        "diff_lambda_q2": nrm(ks[19], (L, DIFF_HEAD_DIM), 0.1),
        "diff_lambda_k2": nrm(ks[20], (L, DIFF_HEAD_DIM), 0.1),
        "diff_sub_gain": 1.0 + nrm(ks[21], (L, DIFF_VAL_DIM), 0.01),
        "w_branch_ssm": nrm(ks[22], (L, SSM_WIDTH, D_MODEL), SSM_WIDTH ** -0.5),
        "w_branch_ret": nrm(ks[23], (L, RET_WIDTH, D_MODEL), RET_WIDTH ** -0.5),
        "w_branch_diff": nrm(ks[24], (L, DIFF_WIDTH, D_MODEL), DIFF_WIDTH ** -0.5),
        "w_out": nrm(ks[25], (L, D_MODEL, D_MODEL), D_MODEL ** -0.5),
    }


def reference(x, norm_w, ffn_w_in, ffn_w_out, mix_w_in, ssm_lambda_re, ssm_lambda_im, ssm_log_dt,
              ssm_b_re, ssm_b_im, ssm_c_re, ssm_c_im, ssm_d, ssm_glu_w, ssm_glu_b,
              diff_q_gain, diff_k_gain, diff_lambda_q1, diff_lambda_k1, diff_lambda_q2, diff_lambda_k2,
              diff_sub_gain, w_branch_ssm, w_branch_ret, w_branch_diff, w_out):
    bsz, seq, _ = x.shape
    h = x
    for layer in range(DEPTH):
        h = h + 0.5 * swiglu(rms_norm(h, norm_w[layer, 0]), ffn_w_in[layer, 0], ffn_w_out[layer, 0])
        xn = rms_norm(h, norm_w[layer, 1])
        u, rq, rk, rv, rg, dq, dk, dv, gates = jnp.split(xn @ mix_w_in[layer], _split_points(), axis=-1)
        y_ssm = s5_branch(u, ssm_lambda_re[layer], ssm_lambda_im[layer], ssm_log_dt[layer],
                          ssm_b_re[layer], ssm_b_im[layer], ssm_c_re[layer], ssm_c_im[layer],
                          ssm_d[layer], ssm_glu_w[layer], ssm_glu_b[layer])
        y_ret = retention_branch(rq.reshape(bsz, seq, RET_HEADS, RET_KEY_DIM),
                                 rk.reshape(bsz, seq, RET_HEADS, RET_KEY_DIM), rv, rg)
        lambda_init = 0.8 - 0.6 * math.exp(-0.3 * layer)
        y_diff = diff_attention_branch(dq.reshape(bsz, seq, DIFF_HEADS, 2, DIFF_HEAD_DIM),
                                       dk.reshape(bsz, seq, DIFF_HEADS, 2, DIFF_HEAD_DIM), dv,
                                       diff_q_gain[layer], diff_k_gain[layer],
                                       diff_lambda_q1[layer], diff_lambda_k1[layer],
                                       diff_lambda_q2[layer], diff_lambda_k2[layer],
                                       diff_sub_gain[layer], lambda_init)
        g = jax.nn.sigmoid(gates.reshape(bsz, seq, N_BRANCH, D_MODEL))
        merged = (g[:, :, 0] * (y_ssm @ w_branch_ssm[layer])
                  + g[:, :, 1] * (y_ret @ w_branch_ret[layer])
                  + g[:, :, 2] * (y_diff @ w_branch_diff[layer]))
        h = h + merged @ w_out[layer]
        h = h + 0.5 * swiglu(rms_norm(h, norm_w[layer, 2]), ffn_w_in[layer, 1], ffn_w_out[layer, 1])
    return h
```

```cpp
#include <hip/hip_runtime.h>
#include <cstdio>
#include <cstdint>
namespace pg8 {
#define PG8_LAS __attribute__((address_space(3)))
typedef unsigned short bf16_t;
typedef short bf16x8 __attribute__((ext_vector_type(8)));
typedef float f32x4 __attribute__((ext_vector_type(4)));
typedef unsigned u32x4 __attribute__((ext_vector_type(4)));
constexpr int BM = 256, BK = 64, HALF = 128, HTB = HALF * BK * 2  , STAGE_BYTES = 8 * HTB, NXCD = 8, WGM = 8;

__host__ __device__ __forceinline__ int lds_byte(int r, int c) { const int st = (r >> 4) * 2 + (c >> 5), rr = r & 15, cc = c & 31, ob = rr * 64 + cc * 2; return st * 1024 + (ob ^ (((ob >> 9) & 1) << 5)); }
__host__ __device__ __forceinline__ void stage_rc(int b, int& R, int& C) { const int st = b / 1024, sb = b % 1024, swz = sb ^ (((sb >> 9) & 1) << 5); R = (st >> 1) * 16 + swz / 64; C = (st & 1) * 32 + (swz % 64) / 2; }
__host__ __device__ __forceinline__ int perm32(int rho) { const int n = rho >> 4, i = rho & 15; return 8 * (i >> 2) + 4 * n + (i & 3); }

struct Unit { int pm, pn; };
struct Gemm { const bf16_t* A; const bf16_t* Bt; int M, N, K; };

struct StaticOrder {
    int nM, nN, nwg, G, c;
    __host__ __device__ void init(int M, int N, int G_, int c_) { nM = M / BM; nN = N / BM; nwg = nM * nN; G = G_; c = c_; }
    __host__ __device__ bool next(int i, Unit& u) const {
        const long L = (long)i * G + c; if (L >= nwg) return false;
        int wgid = (int)L; { const int q = nwg / NXCD, r = nwg % NXCD, xcd = wgid % NXCD, off = wgid / NXCD; wgid = (xcd < r ? xcd * (q + 1) : r * (q + 1) + (xcd - r) * q) + off; }
        const int nig = WGM * nN, gid = wgid / nig, fm = gid * WGM, gsz = (nM - fm) < WGM ? (nM - fm) : WGM;
        u.pm = fm + ((wgid % nig) % gsz); u.pn = (wgid % nig) / gsz; return true;
    }
    __device__ __forceinline__ void a_ready(const Unit&) const {}
    __device__ __forceinline__ void done(const Unit&) const {}
};

__device__ __forceinline__ unsigned cvt_pk_bf16(float lo, float hi) { unsigned r; asm volatile("v_cvt_pk_bf16_f32 %0, %1, %2" : "=v"(r) : "v"(lo), "v"(hi)); return r; }
__device__ __forceinline__ float bf_lo(unsigned w) { return __uint_as_float(w << 16); }
__device__ __forceinline__ float bf_hi(unsigned w) { return __uint_as_float(w & 0xffff0000u); }
__device__ __forceinline__ float sigm(float v) { return __builtin_amdgcn_rcpf(1.0f + __builtin_amdgcn_exp2f(-1.4426950408889634f * v)); }


__device__ __forceinline__ void row_scales_phase(const float* ssq, float inv_d, float eps, PG8_LAS float* rsl, int pm0, int tid) {
    for (int row = tid; row < 8 * BM; row += 512) {
        const f32x4* sp = (const f32x4*)(ssq + ((size_t)pm0 * BM + row) * 64);
        f32x4 s4 = sp[0];
#pragma unroll
        for (int q = 1; q < 16; ++q) s4 += sp[q];
        rsl[row] = 1.0f / sqrtf(((s4[0] + s4[1]) + (s4[2] + s4[3])) * inv_d + eps);
    }
    __syncthreads();
}
struct EpiSwiglu {
    static constexpr bool PERM = true, AFTER_DRAIN = false, MID = false; static constexpr int T0 = -1, T1 = -1;
    bf16_t* O; int ldc; const float* ssq; float inv_d, eps; PG8_LAS float* rsl; int pm0;
    __device__ __forceinline__ void mid(f32x4 (&acc)[2][2][4][2], const Unit& u, int t, int wr, int wc, int fr, int fq) const {}
    __device__ __forceinline__ void operator()(const f32x4 (&acc)[2][2][4][2], const Unit& u, int wr, int wc, int fr, int fq) const {
        const int row0 = u.pm * BM + wr * 64 + fr, col0 = u.pn * HALF + wc * 32 + 8 * fq;
#pragma unroll
        for (int ai = 0; ai < 2; ++ai)
#pragma unroll
            for (int m = 0; m < 4; ++m) { bf16_t* rowp = O + (size_t)(row0 + ai * HALF + m * 16) * ldc + col0;
                float h[8]; const float rs = ssq ? rsl[(u.pm - pm0) * BM + wr * 64 + ai * HALF + m * 16 + fr] : 1.0f;
#pragma unroll
                for (int n = 0; n < 2; ++n)
#pragma unroll
                    for (int j = 0; j < 4; ++j) { const float g = acc[ai][0][m][n][j] * rs, up = acc[ai][1][m][n][j] * rs; h[n * 4 + j] = g * sigm(g) * up; }
                u32x4 w; w.x = cvt_pk_bf16(h[0], h[1]); w.y = cvt_pk_bf16(h[2], h[3]); w.z = cvt_pk_bf16(h[4], h[5]); w.w = cvt_pk_bf16(h[6], h[7]);
                *(u32x4*)rowp = w; }
    }
};
struct EpiResid {
    static constexpr bool PERM = true, AFTER_DRAIN = false, MID = false; static constexpr int T0 = -1, T1 = -1;
    const float* base; float* out; int ldc; float scale; bf16_t* XN; const float* gain; float* ssq;
    __device__ __forceinline__ void mid(f32x4 (&acc)[2][2][4][2], const Unit& u, int t, int wr, int wc, int fr, int fq) const {}
    __device__ __forceinline__ void operator()(const f32x4 (&acc)[2][2][4][2], const Unit& u, int wr, int wc, int fr, int fq) const {
        const int row0 = u.pm * BM + wr * 64 + fr, col0 = u.pn * BM + wc * 32 + 8 * fq;
        f32x4 g[2][2];
        if (XN) {
#pragma unroll
            for (int bj = 0; bj < 2; ++bj) { g[bj][0] = *(const f32x4*)(gain + col0 + bj * HALF); g[bj][1] = *(const f32x4*)(gain + col0 + bj * HALF + 4); } }
#pragma unroll
        for (int ai = 0; ai < 2; ++ai)
#pragma unroll
            for (int m = 0; m < 4; ++m) { const size_t off = (size_t)(row0 + ai * HALF + m * 16) * ldc + col0; float ss = 0.f;
#pragma unroll
                for (int bj = 0; bj < 2; ++bj) { const f32x4 b0 = *(const f32x4*)(base + off + bj * HALF), b1 = *(const f32x4*)(base + off + bj * HALF + 4);
                    const f32x4 o0 = b0 + scale * acc[ai][bj][m][0], o1 = b1 + scale * acc[ai][bj][m][1];
                    *(f32x4*)(out + off + bj * HALF) = o0; *(f32x4*)(out + off + bj * HALF + 4) = o1;
                    if (XN) { ss += ((o0[0] * o0[0] + o0[1] * o0[1]) + (o0[2] * o0[2] + o0[3] * o0[3])) + ((o1[0] * o1[0] + o1[1] * o1[1]) + (o1[2] * o1[2] + o1[3] * o1[3]));
                        u32x4 w; w.x = cvt_pk_bf16(o0[0] * g[bj][0][0], o0[1] * g[bj][0][1]); w.y = cvt_pk_bf16(o0[2] * g[bj][0][2], o0[3] * g[bj][0][3]);
                        w.z = cvt_pk_bf16(o1[0] * g[bj][1][0], o1[1] * g[bj][1][1]); w.w = cvt_pk_bf16(o1[2] * g[bj][1][2], o1[3] * g[bj][1][3]);
                        *(u32x4*)(XN + off + bj * HALF) = w; } }
                if (XN) { ss += __shfl_xor(ss, 16); ss += __shfl_xor(ss, 32); if (fq == 0) ssq[(size_t)(row0 + ai * HALF + m * 16) * 64 + u.pn * 4 + wc] = ss; }
                asm volatile("" ::: "memory"); }
    }
};
struct EpiMix {
    static constexpr bool PERM = true, AFTER_DRAIN = false, MID = false; static constexpr int T0 = -1, T1 = -1;
    bf16_t* O; int ldc; int gate_pn; const float* ssq; float inv_d, eps; PG8_LAS float* rsl; int pm0;
    __device__ __forceinline__ void mid(f32x4 (&acc)[2][2][4][2], const Unit& u, int t, int wr, int wc, int fr, int fq) const {}
    __device__ __forceinline__ void operator()(const f32x4 (&acc)[2][2][4][2], const Unit& u, int wr, int wc, int fr, int fq) const {
        const int row0 = u.pm * BM + wr * 64 + fr, col0 = u.pn * BM + wc * 32 + 8 * fq; const bool gate = u.pn >= gate_pn;
#pragma unroll
        for (int ai = 0; ai < 2; ++ai)
#pragma unroll
            for (int m = 0; m < 4; ++m) { bf16_t* rowp = O + (size_t)(row0 + ai * HALF + m * 16) * ldc + col0; const float rs = rsl[(u.pm - pm0) * BM + wr * 64 + ai * HALF + m * 16 + fr];
#pragma unroll
                for (int bj = 0; bj < 2; ++bj) { f32x4 v0 = acc[ai][bj][m][0] * rs, v1 = acc[ai][bj][m][1] * rs;
                    if (gate) {
#pragma unroll
                        for (int j = 0; j < 4; ++j) { v0[j] = sigm(fminf(fmaxf(v0[j], -30.f), 30.f)); v1[j] = sigm(fminf(fmaxf(v1[j], -30.f), 30.f)); } }
                    u32x4 w; w.x = cvt_pk_bf16(v0[0], v0[1]); w.y = cvt_pk_bf16(v0[2], v0[3]); w.z = cvt_pk_bf16(v1[0], v1[1]); w.w = cvt_pk_bf16(v1[2], v1[3]);
                    *(u32x4*)(rowp + bj * HALF) = w; } }
    }
};
struct EpiGlu {
    static constexpr bool PERM = true, AFTER_DRAIN = false, MID = false; static constexpr int T0 = -1, T1 = -1;
    const bf16_t* Y; int ldy; bf16_t* O; int ldo; const float* bias;
    __device__ __forceinline__ void mid(f32x4 (&acc)[2][2][4][2], const Unit& u, int t, int wr, int wc, int fr, int fq) const {}
    __device__ __forceinline__ void operator()(const f32x4 (&acc)[2][2][4][2], const Unit& u, int wr, int wc, int fr, int fq) const {
        const int row0 = u.pm * BM + wr * 64 + fr, col0 = u.pn * BM + wc * 32 + 8 * fq;
#pragma unroll
        for (int bj = 0; bj < 2; ++bj) { const f32x4 b0 = *(const f32x4*)(bias + col0 + bj * HALF), b1 = *(const f32x4*)(bias + col0 + bj * HALF + 4);
#pragma unroll
            for (int ai = 0; ai < 2; ++ai)
#pragma unroll
                for (int m = 0; m < 4; ++m) { const int r = row0 + ai * HALF + m * 16;
                    const u32x4 y = *(const u32x4*)(Y + (size_t)r * ldy + col0 + bj * HALF);
                    const f32x4 v0 = acc[ai][bj][m][0] + b0, v1 = acc[ai][bj][m][1] + b1;
                    u32x4 w; w.x = cvt_pk_bf16(bf_lo(y.x) * sigm(v0[0]), bf_hi(y.x) * sigm(v0[1])); w.y = cvt_pk_bf16(bf_lo(y.y) * sigm(v0[2]), bf_hi(y.y) * sigm(v0[3]));
                    w.z = cvt_pk_bf16(bf_lo(y.z) * sigm(v1[0]), bf_hi(y.z) * sigm(v1[1])); w.w = cvt_pk_bf16(bf_lo(y.w) * sigm(v1[2]), bf_hi(y.w) * sigm(v1[3]));
                    *(u32x4*)(O + (size_t)r * ldo + col0 + bj * HALF) = w; } }
    }
};
struct EpiBranch {
    static constexpr bool PERM = true, AFTER_DRAIN = false, MID = true; static constexpr int T0 = 16, T1 = 40;
    const bf16_t* G; int ldg; bf16_t* O; int ldo;
    __device__ __forceinline__ void mid(f32x4 (&acc)[2][2][4][2], const Unit& u, int t, int wr, int wc, int fr, int fq) const {
        int fr_l = fr, fq_l = fq; asm volatile("" : "+v"(fr_l), "+v"(fq_l));
        const int row0 = u.pm * BM + wr * 64 + fr_l, col0 = u.pn * BM + wc * 32 + 8 * fq_l; const int ga = (t == T0) ? 0 : 4096;
#pragma unroll
        for (int ai = 0; ai < 2; ++ai)
#pragma unroll
            for (int m = 0; m < 4; ++m) { const bf16_t* gp = G + (size_t)(row0 + ai * HALF + m * 16) * ldg + col0 + ga;
#pragma unroll
                for (int bj = 0; bj < 2; ++bj) { const u32x4 a = *(const u32x4*)(gp + bj * HALF), b = *(const u32x4*)(gp + bj * HALF + 4096);
                    f32x4 r0, r1;
                    r0[0] = bf_lo(a.x) * __builtin_amdgcn_rcpf(bf_lo(b.x)); r0[1] = bf_hi(a.x) * __builtin_amdgcn_rcpf(bf_hi(b.x)); r0[2] = bf_lo(a.y) * __builtin_amdgcn_rcpf(bf_lo(b.y)); r0[3] = bf_hi(a.y) * __builtin_amdgcn_rcpf(bf_hi(b.y));
                    r1[0] = bf_lo(a.z) * __builtin_amdgcn_rcpf(bf_lo(b.z)); r1[1] = bf_hi(a.z) * __builtin_amdgcn_rcpf(bf_hi(b.z)); r1[2] = bf_lo(a.w) * __builtin_amdgcn_rcpf(bf_lo(b.w)); r1[3] = bf_hi(a.w) * __builtin_amdgcn_rcpf(bf_hi(b.w));
                    acc[ai][bj][m][0] *= r0; acc[ai][bj][m][1] *= r1; }
                asm volatile("" ::: "memory"); }
    }
    __device__ __forceinline__ void operator()(const f32x4 (&acc)[2][2][4][2], const Unit& u, int wr, int wc, int fr, int fq) const {
        const int row0 = u.pm * BM + wr * 64 + fr, col0 = u.pn * BM + wc * 32 + 8 * fq;
#pragma unroll
        for (int ai = 0; ai < 2; ++ai)
#pragma unroll
            for (int m = 0; m < 4; ++m) { const int r = row0 + ai * HALF + m * 16;
#pragma unroll
                for (int bj = 0; bj < 2; ++bj) { const u32x4 g = *(const u32x4*)(G + (size_t)r * ldg + col0 + bj * HALF + 8192);
                    const f32x4 v0 = acc[ai][bj][m][0], v1 = acc[ai][bj][m][1];
                    u32x4 w; w.x = cvt_pk_bf16(v0[0] * bf_lo(g.x), v0[1] * bf_hi(g.x)); w.y = cvt_pk_bf16(v0[2] * bf_lo(g.y), v0[3] * bf_hi(g.y));
                    w.z = cvt_pk_bf16(v1[0] * bf_lo(g.z), v1[1] * bf_hi(g.z)); w.w = cvt_pk_bf16(v1[2] * bf_lo(g.w), v1[3] * bf_hi(g.w));
                    *(u32x4*)(O + (size_t)r * ldo + col0 + bj * HALF) = w; }
                asm volatile("" ::: "memory"); }
    }
};
template <class Epi, class Sched, bool ALIGN_EPI = false, bool SP2 = false>
__device__ __forceinline__ void gemm_phase(PG8_LAS unsigned char* lds, const Gemm g, const Sched& S, const Epi& E) {
    int tid_l = threadIdx.x; asm volatile("" : "+v"(tid_l));
    const int tid = tid_l, wid = __builtin_amdgcn_readfirstlane(tid >> 6), lane = tid & 63, wr = wid >> 2, wc = wid & 3, fr = lane & 15, fq = lane >> 4;
    const int K = g.K, nt = K / BK;
    unsigned voffA[2], voffB[2];
#pragma unroll
    for (int i = 0; i < 2; ++i) { int R, C; stage_rc(tid * 16 + i * 8192, R, C); const int Rb = Epi::PERM ? ((R & ~31) + perm32(R & 31)) : R;
        voffA[i] = (unsigned)(R * K + C) * 2u; voffB[i] = (unsigned)(Rb * K + C) * 2u; }
    const size_t kstep = (size_t)(BK * 2);
    const size_t hstep = (size_t)HALF * K * 2;
    const size_t tstep = 2 * hstep;
    const unsigned ldsw = (unsigned)wid * 1024u;
    const int aoff = lds_byte(wr * 64 + fr, fq * 8), boff = lds_byte(wc * 32 + fr, fq * 8);
#define PG8_SA(b, h) (((b) * 2 + (h)) * HTB)
#define PG8_SB(b, h) ((4 + (b) * 2 + (h)) * HTB)
#define PG8_STAGE(bufoff, gbase, voff) do { _Pragma("unroll") for (int _i = 0; _i < 2; ++_i) \
        __builtin_amdgcn_global_load_lds((const unsigned*)((const char*)(gbase) + (voff)[_i]), (PG8_LAS unsigned*)(lds + (bufoff) + ldsw + _i * 8192), 16, 0, 0); } while (0)
#define PG8_LDA(dst, b, h) do { _Pragma("unroll") for (int m = 0; m < 4; ++m) _Pragma("unroll") for (int k = 0; k < 2; ++k) dst[m][k] = *(const PG8_LAS bf16x8*)(lds + PG8_SA(b, h) + aoff + m * 2048 + k * 1024); } while (0)
#define PG8_LDB(dst, b, h) do { _Pragma("unroll") for (int n = 0; n < 2; ++n) _Pragma("unroll") for (int k = 0; k < 2; ++k) dst[n][k] = *(const PG8_LAS bf16x8*)(lds + PG8_SB(b, h) + boff + n * 2048 + k * 1024); } while (0)
#define PG8_MMA(ai, bj, At, Bt) do { __builtin_amdgcn_s_setprio(1); _Pragma("unroll") for (int m = 0; m < 4; ++m) _Pragma("unroll") for (int n = 0; n < 2; ++n) _Pragma("unroll") for (int k = 0; k < 2; ++k) \
        acc[ai][bj][m][n] = __builtin_amdgcn_mfma_f32_16x16x32_bf16(Bt[n][k], At[m][k], acc[ai][bj][m][n], 0, 0, 0); __builtin_amdgcn_s_setprio(0); } while (0)
#define PG8_WAIT_V(n) asm volatile("s_waitcnt vmcnt(" #n ")" ::: "memory")
#define PG8_WAIT_L(n) asm volatile("s_waitcnt lgkmcnt(" #n ")" ::: "memory")
#define PG8_BAR __builtin_amdgcn_s_barrier()
#define PG8_SCHED __builtin_amdgcn_sched_barrier(0)
    Unit cur, nxt; int ui = 0;
    if (!S.next(0, cur)) return;
    f32x4 acc[2][2][4][2];
#pragma unroll
    for (int a = 0; a < 2; ++a)
#pragma unroll
        for (int b = 0; b < 2; ++b)
#pragma unroll
            for (int m = 0; m < 4; ++m)
#pragma unroll
                for (int n = 0; n < 2; ++n) acc[a][b][m][n] = (f32x4){0.f, 0.f, 0.f, 0.f};
    bf16x8 At[4][2], B0[2][2], B1[2][2];
    const char* cA = (const char*)g.A + (size_t)cur.pm * tstep; const char* cB = (const char*)g.Bt + (size_t)cur.pn * tstep;
    S.a_ready(cur);
    if constexpr (SP2) {
        PG8_STAGE(PG8_SB(0, 0), cB, voffB); PG8_STAGE(PG8_SB(0, 1), cB + hstep, voffB); PG8_STAGE(PG8_SA(0, 0), cA, voffA); PG8_STAGE(PG8_SA(0, 1), cA + hstep, voffA);
        if (wr == 1) PG8_BAR;
        PG8_WAIT_V(2); PG8_BAR;
        PG8_STAGE(PG8_SB(1, 0), cB + kstep, voffB); PG8_STAGE(PG8_SA(1, 0), cA + kstep, voffA); PG8_STAGE(PG8_SB(1, 1), cB + hstep + kstep, voffB);
        PG8_WAIT_V(6); PG8_BAR;
    } else {
        PG8_STAGE(PG8_SB(0, 0), cB, voffB); PG8_STAGE(PG8_SA(0, 0), cA, voffA); PG8_STAGE(PG8_SB(0, 1), cB + hstep, voffB); PG8_STAGE(PG8_SA(0, 1), cA + hstep, voffA);
        if (wr == 1) PG8_BAR;
        PG8_WAIT_V(4); PG8_BAR;
        PG8_STAGE(PG8_SB(1, 0), cB + kstep, voffB); PG8_STAGE(PG8_SA(1, 0), cA + kstep, voffA); PG8_STAGE(PG8_SB(1, 1), cB + hstep + kstep, voffB);
        PG8_WAIT_V(6); PG8_BAR;
    }
    for (;;) {
        const bool has_next = S.next(ui + 1, nxt);
        const char* nA = has_next ? (const char*)g.A + (size_t)nxt.pm * tstep : cA; const char* nB = has_next ? (const char*)g.Bt + (size_t)nxt.pn * tstep : cB;
        for (int t = 0; t < nt; t += 2) {
            const bool last = (t == nt - 2);
            const char* a1 = cA + (size_t)(t + 1) * kstep;
            const char* a2 = last ? nA : cA + (size_t)(t + 2) * kstep; const char* b2 = last ? nB : cB + (size_t)(t + 2) * kstep;
            const char* a3 = a2 + kstep; const char* b3 = b2 + kstep;
            if (last && has_next) S.a_ready(nxt);
            if constexpr (Epi::MID) { if (t == Epi::T0 || t == Epi::T1) E.mid(acc, cur, t, wr, wc, fr, fq); }
            if constexpr (SP2) {
            PG8_LDB(B0, 0, 0); PG8_LDB(B1, 0, 1); PG8_SCHED; PG8_LDA(At, 0, 0); PG8_STAGE(PG8_SA(1, 1), a1 + hstep, voffA);
            PG8_WAIT_V(8); PG8_WAIT_L(0); PG8_BAR; PG8_MMA(0, 0, At, B0); PG8_MMA(0, 1, At, B1); PG8_BAR; PG8_SCHED;
            PG8_LDA(At, 0, 1); PG8_STAGE(PG8_SB(0, 0), b2, voffB); PG8_STAGE(PG8_SB(0, 1), b2 + hstep, voffB); PG8_STAGE(PG8_SA(0, 0), a2, voffA);
            PG8_WAIT_V(8); PG8_WAIT_L(0); PG8_BAR; PG8_MMA(1, 0, At, B0); PG8_MMA(1, 1, At, B1); PG8_BAR; PG8_SCHED;
            PG8_LDB(B0, 1, 0); PG8_LDB(B1, 1, 1); PG8_SCHED; PG8_LDA(At, 1, 0); PG8_STAGE(PG8_SA(0, 1), a2 + hstep, voffA);
            PG8_WAIT_V(8); PG8_WAIT_L(0); PG8_BAR; PG8_MMA(0, 0, At, B0); PG8_MMA(0, 1, At, B1); PG8_BAR; PG8_SCHED;
            PG8_LDA(At, 1, 1); PG8_STAGE(PG8_SB(1, 0), b3, voffB); PG8_STAGE(PG8_SB(1, 1), b3 + hstep, voffB); PG8_STAGE(PG8_SA(1, 0), a3, voffA);
            PG8_WAIT_V(8); PG8_WAIT_L(0); PG8_BAR; PG8_MMA(1, 0, At, B0); PG8_MMA(1, 1, At, B1); PG8_BAR; PG8_SCHED;
            } else {
            PG8_LDB(B0, 0, 0); PG8_SCHED; PG8_LDA(At, 0, 0); PG8_STAGE(PG8_SA(1, 1), a1 + hstep, voffA);
            PG8_WAIT_L(8); PG8_BAR; PG8_WAIT_L(0); PG8_MMA(0, 0, At, B0); PG8_BAR; PG8_SCHED;
            PG8_LDB(B1, 0, 1); PG8_STAGE(PG8_SB(0, 0), b2, voffB);
            PG8_BAR; PG8_WAIT_L(0); PG8_MMA(0, 1, At, B1); PG8_BAR;
            PG8_LDA(At, 0, 1); PG8_STAGE(PG8_SA(0, 0), a2, voffA);
            PG8_BAR; PG8_WAIT_L(0); PG8_MMA(1, 0, At, B0); PG8_BAR; PG8_SCHED;
            PG8_STAGE(PG8_SB(0, 1), b2 + hstep, voffB);
            PG8_WAIT_V(6); PG8_BAR; PG8_MMA(1, 1, At, B1); PG8_BAR;
            PG8_LDB(B0, 1, 0); PG8_SCHED; PG8_LDA(At, 1, 0); PG8_STAGE(PG8_SA(0, 1), a2 + hstep, voffA);
            PG8_WAIT_L(8); PG8_BAR; PG8_WAIT_L(0); PG8_MMA(0, 0, At, B0); PG8_BAR; PG8_SCHED;
            PG8_LDB(B1, 1, 1); PG8_STAGE(PG8_SB(1, 0), b3, voffB);
            PG8_BAR; PG8_WAIT_L(0); PG8_MMA(0, 1, At, B1); PG8_BAR;
            PG8_LDA(At, 1, 1); PG8_STAGE(PG8_SA(1, 0), a3, voffA);
            PG8_BAR; PG8_WAIT_L(0); PG8_MMA(1, 0, At, B0); PG8_BAR; PG8_SCHED;
            PG8_STAGE(PG8_SB(1, 1), b3 + hstep, voffB);
            PG8_WAIT_V(6); PG8_BAR; PG8_MMA(1, 1, At, B1); PG8_BAR;
            }
        }
        if constexpr (ALIGN_EPI) { if (wr == 0) PG8_BAR; }
        if constexpr (!Epi::AFTER_DRAIN) { E(acc, cur, wr, wc, fr, fq); S.done(cur); }
        if (!has_next) break;
#pragma unroll
        for (int a = 0; a < 2; ++a)
#pragma unroll
            for (int b = 0; b < 2; ++b)
#pragma unroll
                for (int m = 0; m < 4; ++m)
#pragma unroll
                    for (int n = 0; n < 2; ++n) acc[a][b][m][n] = (f32x4){0.f, 0.f, 0.f, 0.f};
        cur = nxt; cA = nA; cB = nB; ++ui;
        if constexpr (ALIGN_EPI) { if (wr == 1) PG8_BAR; }
    }
    PG8_WAIT_V(0);
    if constexpr (!ALIGN_EPI) { if (wr == 0) PG8_BAR; }
    PG8_BAR;
    if constexpr (Epi::AFTER_DRAIN) { E.fused(acc, cur, wr, wc, fr, fq, lds, wid, lane); S.done(cur); }
#undef PG8_SA
#undef PG8_SB
#undef PG8_STAGE
#undef PG8_LDA
#undef PG8_LDB
#undef PG8_MMA
#undef PG8_WAIT_V
#undef PG8_WAIT_L
#undef PG8_BAR
#undef PG8_SCHED
}
}

#define GAS __attribute__((address_space(1)))
#define LAS __attribute__((address_space(3)))
typedef unsigned short bf16;
typedef unsigned v4u __attribute__((ext_vector_type(4)));
typedef unsigned v2u __attribute__((ext_vector_type(2)));
typedef float f32x4 __attribute__((ext_vector_type(4)));
typedef float f32x16 __attribute__((ext_vector_type(16)));
typedef float f32x2v __attribute__((ext_vector_type(2)));
typedef short bf16x8 __attribute__((ext_vector_type(8)));
typedef short v4i16_t __attribute__((ext_vector_type(4)));
typedef GAS unsigned gu32;
#define RLX_AGENT __ATOMIC_RELAXED, __HIP_MEMORY_SCOPE_AGENT
#define LDS_WAIT() asm volatile("s_waitcnt lgkmcnt(0)" ::: "memory")
#define VM_WAIT() asm volatile("s_waitcnt vmcnt(0)" ::: "memory")
__device__ __forceinline__ unsigned pk2(float lo, float hi) { return pg8::cvt_pk_bf16(lo, hi); }
__device__ __forceinline__ float bflo(unsigned w) { return __uint_as_float(w << 16); }
__device__ __forceinline__ float bfhi(unsigned w) { return __uint_as_float(w & 0xffff0000u); }
__device__ __forceinline__ float ex2(float x) { return __builtin_amdgcn_exp2f(x); }
__device__ __forceinline__ float sigm(float v) { return __builtin_amdgcn_rcpf(1.0f + __builtin_amdgcn_exp2f(-1.4426950408889634f * v)); }

#define XB_TMO      128
#define XB_XCNT(j)  (256  + 64 * (j))
#define XB_XSUB(j)  (1280 + 64 * (j))
#define XB_XGEN(j)  (2304 + 64 * (j))
#define XB_TOP      3328
#define XB_TOPGEN   3392
#define XCD_BAR_WORDS 3456
#define XB_SPIN_CAP (1u << 18)

__device__ __forceinline__ unsigned xb_ld(unsigned* p)              { return __hip_atomic_load(p, __ATOMIC_RELAXED, __HIP_MEMORY_SCOPE_AGENT); }
__device__ __forceinline__ unsigned xb_add(unsigned* p, unsigned v) { return __hip_atomic_fetch_add(p, v, __ATOMIC_RELAXED, __HIP_MEMORY_SCOPE_AGENT); }
__device__ __forceinline__ unsigned xb_xcc_id() { return (unsigned)__builtin_amdgcn_s_getreg((3 << 11) | 20) & 0xFu; }
#define XB_SPIN(cond, bar) do { unsigned _sp = 0; while (cond) { __builtin_amdgcn_s_sleep(1); \
    if ((++_sp & 255u) == 0u) { if (xb_ld(&(bar)[XB_TMO])) break; if (_sp > XB_SPIN_CAP) { atomicAdd(&(bar)[XB_TMO], 1u); break; } } } } while (0)

struct XcdBarrier {
    unsigned* bar; unsigned x;
    volatile LAS unsigned* st;
};

__device__ __forceinline__ XcdBarrier xcd_barrier_post(unsigned* bar, volatile LAS unsigned* st) {
    XcdBarrier b; b.bar = bar; b.x = xb_xcc_id(); b.st = st;
    if (threadIdx.x == 0) (void)xb_add(&bar[XB_XCNT(b.x)], 1u);
    return b;
}
__device__ __forceinline__ void xcd_barrier_complete(unsigned* bar, unsigned x, unsigned& nloc, unsigned& nx) {
    const unsigned G = gridDim.x * gridDim.y * gridDim.z;
    unsigned sum, cnt, mine, sp = 0u;
    for (;;) {
        sum = 0u; cnt = 0u; mine = 0u;
#pragma unroll
        for (unsigned j = 0; j < 16; ++j) { const unsigned c = xb_ld(&bar[XB_XCNT(j)]); sum += c; cnt += (c > 0u) ? 1u : 0u; mine = (j == x) ? c : mine; }
        if (sum == G) break;
        __builtin_amdgcn_s_sleep(1);
        if ((++sp & 255u) == 0u) { if (xb_ld(&bar[XB_TMO])) break; if (sp > XB_SPIN_CAP) { atomicAdd(&bar[XB_TMO], 1u); break; } }
    }
    nloc = mine > 0u ? mine : 1u; nx = cnt > 0u ? cnt : 1u;
}

__device__ __forceinline__ void xcd_barrier(const XcdBarrier& b) {
    asm volatile("s_waitcnt vmcnt(0)" ::: "memory");
    __syncthreads();
    if (threadIdx.x == 0) {
        unsigned* bar = b.bar;
        __builtin_amdgcn_s_waitcnt(0);
        unsigned nloc = b.st[0], nx = b.st[1];
        if (nloc == 0u) { xcd_barrier_complete(bar, b.x, nloc, nx); b.st[0] = nloc; b.st[1] = nx; }
        const unsigned old = xb_add(&bar[XB_XSUB(b.x)], 1u);
        const unsigned gen = old / nloc;
        if (old + 1u == (gen + 1u) * nloc) {
            __builtin_amdgcn_fence(__ATOMIC_RELEASE, "agent");
            asm volatile("s_waitcnt vmcnt(0)" ::: "memory");
            const unsigned og = xb_add(&bar[XB_TOP], 1u);
            const unsigned tg = og / nx;
            if (og + 1u == (tg + 1u) * nx) xb_add(&bar[XB_TOPGEN], 1u);
            else XB_SPIN(xb_ld(&bar[XB_TOPGEN]) == tg, bar);
            __builtin_amdgcn_fence(__ATOMIC_ACQUIRE, "agent");
            xb_add(&bar[XB_XGEN(b.x)], 1u);
            asm volatile("s_waitcnt vmcnt(0)" ::: "memory");
        } else {
            XB_SPIN(xb_ld(&bar[XB_XGEN(b.x)]) == gen, bar);
            __builtin_amdgcn_fence(__ATOMIC_ACQUIRE, "agent");
            asm volatile("s_waitcnt vmcnt(0)" ::: "memory");
        }
    }
    __syncthreads();
}


constexpr int NB = 4, SEQ = 4096, D = 4096, M = NB * SEQ, FF = 11008, NIN = 22528, NLAYER = 2, NWAVES = 8;
constexpr int C_U = 0, C_RQ = 1024, C_RK = 1792, C_RV = 2560, C_RG = 4096, C_DQ = 5632, C_DK = 7168, C_DV = 8704, C_G = 10240;
constexpr float EPS = 1e-6f, LOG2E = 1.4426950408889634f;
constexpr size_t MiB = 1u << 20;
constexpr size_t WS_CTL = 0, CTL_ZERO_BYTES = 1 * MiB;
constexpr int CW_BAR = 4096;
constexpr size_t SZ_WFI = (size_t)2 * FF * D * 2, SZ_WFO = (size_t)D * FF * 2, SZ_WMIX = (size_t)NIN * D * 2, SZ_WGLU = (size_t)1024 * 1024 * 2, SZ_WBR = (size_t)D * D * 2, SZ_WOUT = (size_t)D * D * 2;
constexpr size_t LW_FI0 = 0, LW_FO0 = LW_FI0 + SZ_WFI, LW_MIX = LW_FO0 + SZ_WFO, LW_GLU = LW_MIX + SZ_WMIX, LW_BR = LW_GLU + SZ_WGLU, LW_OUT = LW_BR + SZ_WBR, LW_FI1 = LW_OUT + SZ_WOUT, LW_FO1 = LW_FI1 + SZ_WFI, LW_SIZE = LW_FO1 + SZ_WFO;
constexpr size_t WS_W = 2 * MiB;
constexpr size_t WS_XN = WS_W + NLAYER * LW_SIZE;
constexpr size_t WS_HID = WS_XN + (size_t)M * D * 2;
constexpr size_t WS_MIXO = WS_HID + (size_t)M * FF * 2;
constexpr size_t WS_YPRE = WS_MIXO + (size_t)M * NIN * 2;
constexpr size_t WS_YCAT = WS_YPRE + (size_t)M * 1024 * 2;
constexpr size_t WS_MERGED = WS_YCAT + (size_t)M * D * 2;
constexpr size_t WS_PREVT = WS_MERGED + (size_t)M * D * 2;
constexpr size_t WS_SSQP = WS_PREVT + (size_t)NB * 6 * 32 * 256 * 128 * 2;
constexpr size_t WS_END = WS_SSQP + (size_t)6 * M * 64 * 4;
static_assert(LW_SIZE % 256 == 0 && WS_XN % 256 == 0 && WS_HID % 256 == 0 && WS_MIXO % 256 == 0 && WS_YPRE % 256 == 0, "alignment");
constexpr int RING_BYTES = 131072, LDSCTL_OFF = RING_BYTES, MISC_OFF = LDSCTL_OFF + 320, LDS_BYTES = 147456;

struct Args { const float* in[26]; float* out; unsigned char* ws; int ph_lo, ph_hi; };
enum { I_X = 0, I_NORMW, I_FFNIN, I_FFNOUT, I_MIXIN, I_LRE, I_LIM, I_LOGDT, I_BRE, I_BIM, I_CRE, I_CIM, I_SSMD, I_GLUW, I_GLUB, I_QG, I_KG, I_LQ1, I_LK1, I_LQ2, I_LK2, I_SUBG, I_WBS, I_WBR, I_WBD, I_WOUT };

__device__ __forceinline__ float wave_sum(float v) {
#pragma unroll
    for (int o = 1; o < 64; o <<= 1) v += __shfl_xor(v, o);
    return v;
}
typedef __attribute__((address_space(3))) unsigned char lds_u8;

__device__ __forceinline__ void transpose_item(const float* W, int N, bf16* WT, int ldk, int kofs, int mode, LAS float* scr, int item, int lane) {
    const int nblk = N / 32, kb = item / nblk, nb = item % nblk, k0 = 64 * kb, n0 = 32 * nb;
    int r0 = n0;
    if (mode == 1) { const int half = n0 >= FF ? 1 : 0, j = n0 - half * FF; r0 = (j >> 7) * 256 + half * 128 + (j & 127); }
#pragma unroll 8
    for (int i = 0; i < 32; ++i) { const int kk = 2 * i + (lane >> 5); scr[kk * 33 + (lane & 31)] = W[(size_t)(k0 + kk) * N + n0 + (lane & 31)]; }
    LDS_WAIT(); asm volatile("" ::: "memory");
    const int c = lane & 7;
#pragma unroll
    for (int j = 0; j < 4; ++j) { const int n = (lane >> 3) + 8 * j; const LAS float* s = scr + (8 * c) * 33 + n;
        v4u o; o.x = pk2(s[0 * 33], s[1 * 33]); o.y = pk2(s[2 * 33], s[3 * 33]); o.z = pk2(s[4 * 33], s[5 * 33]); o.w = pk2(s[6 * 33], s[7 * 33]);
        *(GAS v4u*)(WT + (size_t)(r0 + n) * ldk + kofs + k0 + 8 * c) = o; }
    LDS_WAIT(); asm volatile("" ::: "memory");
}
__device__ __forceinline__ void conv_matrix(const float* W, int K, int N, bf16* WT, int ldk, int kofs, int mode, LAS float* scr, int gw, int NGW, int lane) {
    const int nitems = (K / 64) * (N / 32);
    for (int it = gw; it < nitems; it += NGW) transpose_item(W, N, WT, ldk, kofs, mode, scr, it, lane);
}
__device__ __forceinline__ void conv_phase(const Args& a, lds_u8* lds, int gw, int NGW, int lane, int wave) {
    LAS float* scr = (LAS float*)(lds + wave * 16384);
    for (int l = 0; l < NLAYER; ++l) {
        unsigned char* wl = a.ws + WS_W + (size_t)l * LW_SIZE;
        conv_matrix(a.in[I_FFNIN] + (size_t)(l * 2 + 0) * D * 2 * FF, D, 2 * FF, (bf16*)(wl + LW_FI0), D, 0, 1, scr, gw, NGW, lane);
        conv_matrix(a.in[I_FFNOUT] + (size_t)(l * 2 + 0) * FF * D, FF, D, (bf16*)(wl + LW_FO0), FF, 0, 0, scr, gw, NGW, lane);
        conv_matrix(a.in[I_MIXIN] + (size_t)l * D * NIN, D, NIN, (bf16*)(wl + LW_MIX), D, 0, 0, scr, gw, NGW, lane);
        conv_matrix(a.in[I_GLUW] + (size_t)l * 1024 * 1024, 1024, 1024, (bf16*)(wl + LW_GLU), 1024, 0, 0, scr, gw, NGW, lane);
        conv_matrix(a.in[I_WBS] + (size_t)l * 1024 * D, 1024, D, (bf16*)(wl + LW_BR), D, 0, 0, scr, gw, NGW, lane);
        conv_matrix(a.in[I_WBR] + (size_t)l * 1536 * D, 1536, D, (bf16*)(wl + LW_BR), D, 1024, 0, scr, gw, NGW, lane);
        conv_matrix(a.in[I_WBD] + (size_t)l * 1536 * D, 1536, D, (bf16*)(wl + LW_BR), D, 2560, 0, scr, gw, NGW, lane);
        conv_matrix(a.in[I_WOUT] + (size_t)l * D * D, D, D, (bf16*)(wl + LW_OUT), D, 0, 0, scr, gw, NGW, lane);
        conv_matrix(a.in[I_FFNIN] + (size_t)(l * 2 + 1) * D * 2 * FF, D, 2 * FF, (bf16*)(wl + LW_FI1), D, 0, 1, scr, gw, NGW, lane);
        conv_matrix(a.in[I_FFNOUT] + (size_t)(l * 2 + 1) * FF * D, FF, D, (bf16*)(wl + LW_FO1), FF, 0, 0, scr, gw, NGW, lane);
    }
}
__device__ __forceinline__ void norm_phase(const float* x, const float* gain, bf16* xn, int gw, int NGW, int lane) {
    for (int m = gw; m < M; m += NGW) {
        const GAS f32x4* xr = (const GAS f32x4*)(x + (size_t)m * D) + lane;
        f32x4 v[16]; float s = 0.f;
#pragma unroll
        for (int j = 0; j < 16; ++j) { v[j] = xr[64 * j]; s += (v[j].x * v[j].x + v[j].y * v[j].y) + (v[j].z * v[j].z + v[j].w * v[j].w); }
        const float rstd = 1.0f / sqrtf(wave_sum(s) * (1.0f / D) + EPS);
        GAS v2u* o8 = (GAS v2u*)(xn + (size_t)m * D) + lane;
#pragma unroll
        for (int j = 0; j < 16; ++j) { const f32x4 g = ((const GAS f32x4*)gain)[lane + 64 * j]; v2u w; w.x = pk2(v[j].x * rstd * g.x, v[j].y * rstd * g.y); w.y = pk2(v[j].z * rstd * g.z, v[j].w * rstd * g.w); o8[64 * j] = w; }
    }
}
__device__ __forceinline__ float gelu_tanh(float x) { const float z = 0.7978845608028654f * (x + 0.044715f * x * x * x); return x * sigm(2.0f * z); }
#define MFMA16(A, B, C) __builtin_amdgcn_mfma_f32_16x16x32_bf16((A), (B), (C), 0, 0, 0)
__device__ __forceinline__ void ssm_phase(const Args& a, int layer, lds_u8* lds, int lane, int wave, int first, int stride) {
    const bf16* mixo = (const bf16*)(a.ws + WS_MIXO); bf16* ypre = (bf16*)(a.ws + WS_YPRE);
    lds_u8* wb = lds + wave * 13312;
    LAS float* BU = (LAS float*)wb;
    lds_u8* Xs = wb + 8192;
    lds_u8* Ub = wb + 12288;
    lds_u8* Yb = wb + 12800;
    LAS float* sS = (LAS float*)(lds + 106496);
    lds_u8* Bt = lds + 110592;
    lds_u8* Ct = lds + 114688;
    const int l15 = lane & 15, kq = lane >> 4;
    for (int item = first; item < NB * 64; item += stride) {
        const int b = item >> 6, g = item & 63, lg = layer * 64 + g, p = lane;
        const float dt = expf(a.in[I_LOGDT][lg]);
        const float lr = a.in[I_LRE][lg * 64 + p], li = a.in[I_LIM][lg * 64 + p];
        const float mag = expf(lr * dt); float sn, cs; sincosf(li * dt, &sn, &cs);
        const float ar = mag * cs, ai = mag * sn;
        __syncthreads();
        if (wave == 0) {
            const float den = lr * lr + li * li, nr = ar - 1.0f, ni = ai;
            const float cfr = (nr * lr + ni * li) / den, cfi = (ni * lr - nr * li) / den;
            const float* br = a.in[I_BRE] + ((size_t)lg * 64 + p) * 16; const float* bi = a.in[I_BIM] + ((size_t)lg * 64 + p) * 16;
            unsigned wre[8], wim[8];
#pragma unroll
            for (int i = 0; i < 8; ++i) { const float r0 = cfr * br[2 * i] - cfi * bi[2 * i], r1 = cfr * br[2 * i + 1] - cfi * bi[2 * i + 1], i0 = cfr * bi[2 * i] + cfi * br[2 * i], i1 = cfr * bi[2 * i + 1] + cfi * br[2 * i + 1];
                wre[i] = pk2(r0, r1); wim[i] = pk2(i0, i1); }
            *(LAS v4u*)(Bt + (2 * p) * 32) = (v4u){wre[0], wre[1], wre[2], wre[3]}; *(LAS v4u*)(Bt + (2 * p) * 32 + 16) = (v4u){wre[4], wre[5], wre[6], wre[7]};
            *(LAS v4u*)(Bt + (2 * p + 1) * 32) = (v4u){wim[0], wim[1], wim[2], wim[3]}; *(LAS v4u*)(Bt + (2 * p + 1) * 32 + 16) = (v4u){wim[4], wim[5], wim[6], wim[7]};
#pragma unroll
            for (int i = 0; i < 16; ++i) { const float cr_ = a.in[I_CRE][((size_t)lg * 16 + i) * 64 + p], ci_ = a.in[I_CIM][((size_t)lg * 16 + i) * 64 + p];
                *(LAS unsigned*)(Ct + i * 256 + p * 4) = pk2(cr_, -ci_); }
        }
        float pr = ar, pi = ai;
#pragma unroll
        for (int k = 0; k < 9; ++k) { const float n1 = pr * pr - pi * pi, n2 = 2.0f * pr * pi; pr = n1; pi = n2; }
        __syncthreads();
        bf16x8 bfrag[8], cfrag[4];
#pragma unroll
        for (int nb = 0; nb < 8; ++nb) { bfrag[nb] = (bf16x8){0, 0, 0, 0, 0, 0, 0, 0}; if (kq < 2) bfrag[nb] = *(const LAS bf16x8*)(Bt + (16 * nb + l15) * 32 + kq * 16); }
#pragma unroll
        for (int ks = 0; ks < 4; ++ks) cfrag[ks] = *(const LAS bf16x8*)(Ct + l15 * 256 + (32 * ks + 8 * kq) * 2);
        const float dsk = a.in[I_SSMD][lg * 16 + l15];
        const size_t rowbase = (size_t)b * SEQ + wave * 512;
        const bf16* up = mixo + (rowbase + l15) * NIN + C_U + g * 16 + (kq & 1) * 8;
        float xr = 0.f, xi = 0.f;
        for (int pass = 0; pass < 2; ++pass) {
            bf16x8 ufr = *(const bf16x8*)up;
            for (int ch = 0; ch < 32; ++ch) {
                bf16x8 ua = ufr; if (kq >= 2) ua = (bf16x8){0, 0, 0, 0, 0, 0, 0, 0};
                if (ch + 1 < 32) ufr = *(const bf16x8*)(up + (size_t)(ch + 1) * 16 * NIN);
                if (pass == 1 && kq < 2) *(LAS bf16x8*)(Ub + l15 * 32 + kq * 16) = ua;
#pragma unroll
                for (int nb = 0; nb < 8; ++nb) { f32x4 acc = {0.f, 0.f, 0.f, 0.f}; acc = MFMA16(ua, bfrag[nb], acc);
#pragma unroll
                    for (int r = 0; r < 4; ++r) BU[(4 * kq + r) * 128 + 16 * nb + l15] = acc[r]; }
#pragma unroll
                for (int t = 0; t < 16; ++t) { const f32x2v bu = *(const LAS f32x2v*)(BU + t * 128 + 2 * p);
                    const float n1 = ar * xr - ai * xi + bu.x, n2 = ar * xi + ai * xr + bu.y; xr = n1; xi = n2;
                    if (pass == 1) *(LAS unsigned*)(Xs + t * 256 + p * 4) = pk2(xr, xi); }
                if (pass == 1) {
                    f32x4 y = {0.f, 0.f, 0.f, 0.f};
#pragma unroll
                    for (int ks = 0; ks < 4; ++ks) { const bf16x8 xa = *(const LAS bf16x8*)(Xs + l15 * 256 + (32 * ks + 8 * kq) * 2); y = MFMA16(xa, cfrag[ks], y); }
#pragma unroll
                    for (int r = 0; r < 4; ++r) { const int t = 4 * kq + r; const float u = __uint_as_float((unsigned)(*(const LAS unsigned short*)(Ub + t * 32 + l15 * 2)) << 16);
                        *(LAS unsigned short*)(Yb + t * 32 + l15 * 2) = (unsigned short)(pk2(gelu_tanh(y[r] + dsk * u), 0.f) & 0xffffu); }
                    if (lane < 32) *(v4u*)(ypre + (rowbase + ch * 16 + (lane >> 1)) * 1024 + g * 16 + (lane & 1) * 8) = *(const LAS v4u*)(Yb + (lane >> 1) * 32 + (lane & 1) * 16);
                }
            }
            if (pass == 0) {
                sS[(wave * 64 + lane) * 2] = xr; sS[(wave * 64 + lane) * 2 + 1] = xi;
                __syncthreads();
                float ir = 0.f, ii = 0.f;
                for (int v = 0; v < wave; ++v) { const float sr = sS[(v * 64 + lane) * 2], si = sS[(v * 64 + lane) * 2 + 1]; const float n1 = pr * ir - pi * ii + sr, n2 = pr * ii + pi * ir + si; ir = n1; ii = n2; }
                xr = ir; xi = ii;
            }
        }
    }
}
__device__ __forceinline__ void qknorm_phase(const Args& a, int layer, int gw, int NGW, int lane) {
    bf16* mixo = (bf16*)(a.ws + WS_MIXO);
    float gq[8], gk[8];
#pragma unroll
    for (int j = 0; j < 8; ++j) { gq[j] = a.in[I_QG][layer * 64 + (lane & 7) * 8 + j] * (0.125f * LOG2E); gk[j] = a.in[I_KG][layer * 64 + (lane & 7) * 8 + j]; }
    for (int m = gw; m < M; m += NGW) {
#pragma unroll
        for (int part = 0; part < 2; ++part)
#pragma unroll
            for (int it = 0; it < 3; ++it) {
                bf16* p = mixo + (size_t)m * NIN + (part ? C_DK : C_DQ) + it * 512 + lane * 8;
                const v4u w = *(const v4u*)p;
                float f[8] = {bflo(w.x), bfhi(w.x), bflo(w.y), bfhi(w.y), bflo(w.z), bfhi(w.z), bflo(w.w), bfhi(w.w)};
                float ss = 0.f;
#pragma unroll
                for (int j = 0; j < 8; ++j) ss += f[j] * f[j];
                ss += __shfl_xor(ss, 1); ss += __shfl_xor(ss, 2); ss += __shfl_xor(ss, 4);
                const float r = 1.0f / sqrtf(ss * (1.0f / 64.0f) + EPS);
#pragma unroll
                for (int j = 0; j < 8; ++j) f[j] *= r * (part ? gk[j] : gq[j]);
                *(v4u*)p = (v4u){pk2(f[0], f[1]), pk2(f[2], f[3]), pk2(f[4], f[5]), pk2(f[6], f[7])};
            }
    }
}
__device__ __forceinline__ int tr_lane_off(int lane, int rs) { const int i = lane & 15; return (4 * (lane >> 5) + (i >> 2)) * rs + (16 * ((lane >> 4) & 1) + 4 * (i & 3)) * 2; }
__device__ __forceinline__ bf16x8 tr_frag(const lds_u8* p, int rs8) {
    const v4i16_t lo = __builtin_amdgcn_ds_read_tr16_b64_v4i16((LAS v4i16_t*)p), hi = __builtin_amdgcn_ds_read_tr16_b64_v4i16((LAS v4i16_t*)(p + rs8));
    return (bf16x8){lo[0], lo[1], lo[2], lo[3], hi[0], hi[1], hi[2], hi[3]};
}
__device__ __forceinline__ bf16x8 pack8(float a0, float a1, float a2, float a3, float a4, float a5, float a6, float a7) {
    const v4u w = {pk2(a0, a1), pk2(a2, a3), pk2(a4, a5), pk2(a6, a7)}; return __builtin_bit_cast(bf16x8, w);
}
#define MFMA32(A, B, C) __builtin_amdgcn_mfma_f32_32x32x16_bf16((A), (B), (C), 0, 0, 0)
__device__ __forceinline__ f32x16 zero16() { f32x16 z; for (int i = 0; i < 16; ++i) z[i] = 0.f; return z; }

__device__ __forceinline__ void ret_state_phase(const Args& a, lds_u8* lds, int tid, int lane, int wave) {
    constexpr int RS = 320;
    const bf16* mixo = (const bf16*)(a.ws + WS_MIXO); bf16* prevT = (bf16*)(a.ws + WS_PREVT);
    lds_u8* Ks = lds; lds_u8* Vs = lds + 128 * RS;
    const int troff = tr_lane_off(lane, RS), l31 = lane & 31, hh = lane >> 5;
    const int dvb = wave >> 1, dkb0 = (wave & 1) * 2;
    for (int item = (int)gridDim.x - 1 - (int)blockIdx.x; item < NB * 6 * 2; item += gridDim.x) {
        const int dvh = item & 1, h = (item >> 1) % 6, b = item / 12;
        const float lg2 = log2f(1.0f - exp2f(-5.0f - (float)h)), cd = ex2(lg2 * 128.0f);
        f32x16 st0 = zero16(), st1 = zero16();
        v4u kreg[4], vreg[4];
#define RS_LOAD(n) do { _Pragma("unroll") for (int i_ = 0; i_ < 4; ++i_) { const int cid_ = tid + 512 * i_, row_ = cid_ >> 4, cc_ = cid_ & 15; const bf16* rp_ = mixo + ((size_t)b * SEQ + (n) * 128 + row_) * NIN; \
            kreg[i_] = *(const v4u*)(rp_ + C_RK + h * 128 + cc_ * 8); vreg[i_] = *(const v4u*)(rp_ + C_RV + h * 256 + dvh * 128 + cc_ * 8); } } while (0)
        RS_LOAD(0);
        for (int n = 0; n < 32; ++n) {
            bf16* pt = prevT + ((size_t)((b * 6 + h) * 32 + n) * 256 + dvh * 128 + dvb * 32) * 128;
#pragma unroll
            for (int r = 0; r < 16; ++r) { const int dv = (r & 3) + 8 * (r >> 2) + 4 * hh;
                pt[dv * 128 + dkb0 * 32 + l31] = (bf16)(pk2(st0[r], 0.f) & 0xffffu); pt[dv * 128 + (dkb0 + 1) * 32 + l31] = (bf16)(pk2(st1[r], 0.f) & 0xffffu); }
            if (n == 31) break;
            __syncthreads();
#pragma unroll
            for (int i = 0; i < 4; ++i) { const int cid = tid + 512 * i, row = cid >> 4, cc = cid & 15; const float sc = ex2(lg2 * (float)(127 - row)) * 0.08838834764831845f;
                const v4u k = kreg[i];
                const v4u ks = {pk2(bflo(k.x) * sc, bfhi(k.x) * sc), pk2(bflo(k.y) * sc, bfhi(k.y) * sc), pk2(bflo(k.z) * sc, bfhi(k.z) * sc), pk2(bflo(k.w) * sc, bfhi(k.w) * sc)};
                *(LAS v4u*)(Ks + row * RS + cc * 16) = ks; *(LAS v4u*)(Vs + row * RS + cc * 16) = vreg[i]; }
            __syncthreads();
            if (n + 1 < 31) RS_LOAD(n + 1);
            st0 *= cd; st1 *= cd;
#pragma unroll 2
            for (int s = 0; s < 8; ++s) {
                const bf16x8 A = tr_frag(Vs + troff + 16 * s * RS + dvb * 64, 8 * RS);
                const bf16x8 B0 = tr_frag(Ks + troff + 16 * s * RS + dkb0 * 64, 8 * RS), B1 = tr_frag(Ks + troff + 16 * s * RS + (dkb0 + 1) * 64, 8 * RS);
                st0 = MFMA32(A, B0, st0); st1 = MFMA32(A, B1, st1);
            }
        }
#undef RS_LOAD
        __syncthreads();
    }
}
__device__ __forceinline__ void ret_out_phase(const Args& a, lds_u8* lds, int tid, int lane, int wave) {
    constexpr int RK = 272, RV = 576, RO = 528;
    const bf16* mixo = (const bf16*)(a.ws + WS_MIXO); const bf16* prevT = (const bf16*)(a.ws + WS_PREVT); bf16* ycat = (bf16*)(a.ws + WS_YCAT);
    lds_u8* Ks = lds; lds_u8* Vs = lds + 128 * RK; lds_u8* Ps = lds; lds_u8* Os = lds;
    LAS float* ssS = (LAS float*)(lds + 112640);
    const int qb = wave & 3, dvh = wave >> 2, l31 = lane & 31, hh = lane >> 5;
    const int troffV = tr_lane_off(lane, RV);
    for (int item = blockIdx.x; item < NB * 32 * 6; item += gridDim.x) {
        const int h = item % 6, n = (item / 6) & 31, b = item / 192;
        const float lg2 = log2f(1.0f - exp2f(-5.0f - (float)h));
        const size_t row0 = (size_t)b * SEQ + n * 128;
        __syncthreads();
#pragma unroll
        for (int i = 0; i < 4; ++i) { const int cid = tid + 512 * i, row = cid >> 4, cc = cid & 15; const float sc = ex2(-lg2 * (float)(row + 1)) * 0.08838834764831845f;
            const v4u k = *(const v4u*)(mixo + (row0 + row) * NIN + C_RK + h * 128 + cc * 8);
            const v4u ks = {pk2(bflo(k.x) * sc, bfhi(k.x) * sc), pk2(bflo(k.y) * sc, bfhi(k.y) * sc), pk2(bflo(k.z) * sc, bfhi(k.z) * sc), pk2(bflo(k.w) * sc, bfhi(k.w) * sc)};
            *(LAS v4u*)(Ks + row * RK + cc * 16) = ks; }
#pragma unroll 4
        for (int i = 0; i < 8; ++i) { const int cid = tid + 512 * i, row = cid >> 5, cc = cid & 31; *(LAS v4u*)(Vs + row * RV + cc * 16) = *(const v4u*)(mixo + (row0 + row) * NIN + C_RV + h * 256 + cc * 8); }
        bf16x8 qf[8];
        { const bf16* qp = mixo + (row0 + qb * 32 + l31) * NIN + C_RQ + h * 128 + 8 * hh;
#pragma unroll
          for (int s = 0; s < 8; ++s) qf[s] = *(const bf16x8*)(qp + 16 * s); }
        f32x16 o[4];
#pragma unroll
        for (int db = 0; db < 4; ++db) o[db] = zero16();
        __syncthreads();
#pragma unroll
        for (int kb = 0; kb < 4; ++kb) {
            if (kb <= qb) {
                f32x16 st = zero16();
#pragma unroll
                for (int s = 0; s < 8; ++s) { const bf16x8 A = *(const LAS bf16x8*)(Ks + (kb * 32 + l31) * RK + (16 * s + 8 * hh) * 2); st = MFMA32(A, qf[s], st); }
                if (kb == qb) {
#pragma unroll
                    for (int r = 0; r < 16; ++r) if ((r & 3) + 8 * (r >> 2) + 4 * hh > l31) st[r] = 0.f;
                }
                const bf16x8 p0 = pack8(st[0], st[1], st[2], st[3], st[4], st[5], st[6], st[7]), p1 = pack8(st[8], st[9], st[10], st[11], st[12], st[13], st[14], st[15]);
#pragma unroll
                for (int db = 0; db < 4; ++db) { const bf16x8 A0 = tr_frag(Vs + troffV + 32 * kb * RV + (dvh * 128 + db * 32) * 2, 8 * RV), A1 = tr_frag(Vs + troffV + (32 * kb + 16) * RV + (dvh * 128 + db * 32) * 2, 8 * RV);
                    o[db] = MFMA32(A0, p0, o[db]); o[db] = MFMA32(A1, p1, o[db]); }
            }
            __builtin_amdgcn_sched_barrier(0);
        }
        __syncthreads();
        { const bf16* pt = prevT + (size_t)((b * 6 + h) * 32 + n) * 256 * 128;
#pragma unroll 4
          for (int i = 0; i < 8; ++i) { const int cid = tid + 512 * i, row = cid >> 4, cc = cid & 15; *(LAS v4u*)(Ps + row * RK + cc * 16) = *(const v4u*)(pt + row * 128 + cc * 8); } }
        __syncthreads();
#pragma unroll
        for (int db = 0; db < 4; ++db) {
#pragma unroll
            for (int s = 0; s < 8; ++s) { const bf16x8 A = *(const LAS bf16x8*)(Ps + (dvh * 128 + db * 32 + l31) * RK + (16 * s + 8 * hh) * 2); o[db] = MFMA32(A, qf[s], o[db]); }
            __builtin_amdgcn_sched_barrier(0);
        }
        float ss = 0.f;
#pragma unroll
        for (int db = 0; db < 4; ++db)
#pragma unroll
            for (int r = 0; r < 16; ++r) ss += o[db][r] * o[db][r];
        ss += __shfl_xor(ss, 32);
        if (hh == 0) ssS[wave * 32 + l31] = ss;
        __syncthreads();
        const float rstd = 1.0f / sqrtf((ssS[wave * 32 + l31] + ssS[(wave ^ 4) * 32 + l31]) * (1.0f / 256.0f) + EPS * ex2(-2.0f * lg2 * (float)(qb * 32 + l31 + 1)));
#pragma unroll
        for (int db = 0; db < 4; ++db)
#pragma unroll
            for (int rq = 0; rq < 4; ++rq) { const int dv = dvh * 128 + db * 32 + 8 * rq + 4 * hh;
                const v2u w = {pk2(o[db][4 * rq] * rstd, o[db][4 * rq + 1] * rstd), pk2(o[db][4 * rq + 2] * rstd, o[db][4 * rq + 3] * rstd)};
                *(LAS v2u*)(Os + (qb * 32 + l31) * RO + dv * 2) = w; }
        __syncthreads();
#pragma unroll 2
        for (int i = 0; i < 8; ++i) { const int cid = tid + 512 * i, row = cid >> 5, cc = cid & 31;
            const v4u ov = *(const LAS v4u*)(Os + row * RO + cc * 16); const v4u gv = *(const v4u*)(mixo + (row0 + row) * NIN + C_RG + h * 256 + cc * 8);
            float g[8] = {bflo(gv.x), bfhi(gv.x), bflo(gv.y), bfhi(gv.y), bflo(gv.z), bfhi(gv.z), bflo(gv.w), bfhi(gv.w)};
            float ov8[8] = {bflo(ov.x), bfhi(ov.x), bflo(ov.y), bfhi(ov.y), bflo(ov.z), bfhi(ov.z), bflo(ov.w), bfhi(ov.w)};
#pragma unroll
            for (int j = 0; j < 8; ++j) ov8[j] *= g[j] * sigm(g[j]);
            *(v4u*)(ycat + (row0 + row) * D + 1024 + h * 256 + cc * 8) = (v4u){pk2(ov8[0], ov8[1]), pk2(ov8[2], ov8[3]), pk2(ov8[4], ov8[5]), pk2(ov8[6], ov8[7])}; }
    }
}
__device__ __forceinline__ void attn_phase(const Args& a, int layer, lds_u8* lds, int tid, int lane, int wave) {
    constexpr int RK = 144, RV = 320, STG = 2 * 64 * RK + 64 * RV;
    const bf16* mixo = (const bf16*)(a.ws + WS_MIXO); bf16* ycat = (bf16*)(a.ws + WS_YCAT);
    const int l31 = lane & 31, hh = lane >> 5, map = wave >> 2, qs = wave & 3;
    const int troffV = tr_lane_off(lane, RV);
    const float lambda_init = 0.8f - 0.6f * expf(-0.3f * (float)layer);
    float lam;
    { const float s1 = wave_sum(a.in[I_LQ1][layer * 64 + lane] * a.in[I_LK1][layer * 64 + lane]), s2 = wave_sum(a.in[I_LQ2][layer * 64 + lane] * a.in[I_LK2][layer * 64 + lane]);
      lam = expf(s1) - expf(s2) + lambda_init; }
    float thr;
    { float mq = fabsf(a.in[I_QG][layer * 64 + lane]), mk = fabsf(a.in[I_KG][layer * 64 + lane]);
#pragma unroll
      for (int o = 1; o < 64; o <<= 1) { mq = fmaxf(mq, __shfl_xor(mq, o)); mk = fmaxf(mk, __shfl_xor(mk, o)); }
      thr = 152.0f + 2.0f * (8.0f * LOG2E * mq * mk) * 1.01f; }
    LAS unsigned short* order = (LAS unsigned short*)(lds + 122880);
    LAS unsigned char* costs = (LAS unsigned char*)(lds + 124928);
    __syncthreads();
    if (tid < 384) { const int hd_ = tid >> 5, qb_ = tid & 31; const float sl = exp2f(-8.0f * (float)(hd_ + 1) / 12.0f) * LOG2E; const int W = (int)fminf(thr / sl, 100000.0f) + 1;
        const int x = 128 * qb_ - W - 63; const int k0 = x <= 0 ? 0 : (x + 63) >> 6; costs[tid] = (unsigned char)(2 * qb_ + 2 - k0); }
    __syncthreads();
    if (tid < 384) { const int c0 = costs[tid]; int rank = 0; for (int s_ = 0; s_ < 384; ++s_) { const int cs = costs[s_]; rank += (cs > c0 || (cs == c0 && s_ < tid)) ? 1 : 0; } order[rank] = (unsigned short)tid; }
    __syncthreads();
    const int G = gridDim.x, cidx = blockIdx.x;
    for (int rnd = 0;; ++rnd) {
        const int u = rnd * G + ((rnd & 1) ? (G - 1 - cidx) : cidx);
        if (u >= NB * 12 * 32) break;
        const int pair = order[u >> 2], b = u & 3, hd = pair >> 5, qb = pair & 31;
        const float slope2 = exp2f(-8.0f * (float)(hd + 1) / 12.0f) * LOG2E;
        const size_t row0 = (size_t)b * SEQ;
        const int qw = qb * 128 + qs * 32;
        bf16x8 qf[4];
        { const bf16* qp = mixo + (row0 + qw + l31) * NIN + C_DQ + hd * 128 + map * 64 + 8 * hh;
#pragma unroll
          for (int s = 0; s < 4; ++s) qf[s] = *(const bf16x8*)(qp + 16 * s); }
        f32x16 o[4];
#pragma unroll
        for (int db = 0; db < 4; ++db) o[db] = zero16();
        float mrun = -1e30f, lrun = 0.f;
        const int kt1 = 2 * qb + 1; int kt0; { const int W = (int)fminf(thr / slope2, 100000.0f) + 1, x = 128 * qb - W - 63; kt0 = x <= 0 ? 0 : (x + 63) >> 6; }
        v4u rk1, rk2, rv0, rv1;
#define ATT_LOAD(kt) do { const bf16* kp_ = mixo + (row0 + (kt) * 64 + (tid >> 3)) * NIN + C_DK + hd * 128 + (tid & 7) * 8; rk1 = *(const v4u*)kp_; rk2 = *(const v4u*)(kp_ + 64); \
            const bf16* vp_ = mixo + (row0 + (kt) * 64 + (tid >> 4)) * NIN + C_DV + hd * 128 + (tid & 15) * 8; rv0 = *(const v4u*)vp_; rv1 = *(const v4u*)(vp_ + (size_t)32 * NIN); } while (0)
#define ATT_STORE(st) do { lds_u8* sb_ = lds + (st) * STG; *(LAS v4u*)(sb_ + (tid >> 3) * RK + (tid & 7) * 16) = rk1; *(LAS v4u*)(sb_ + 64 * RK + (tid >> 3) * RK + (tid & 7) * 16) = rk2; \
            *(LAS v4u*)(sb_ + 128 * RK + (tid >> 4) * RV + (tid & 15) * 16) = rv0; *(LAS v4u*)(sb_ + 128 * RK + ((tid >> 4) + 32) * RV + (tid & 15) * 16) = rv1; } while (0)
        __syncthreads();
        ATT_LOAD(kt0); ATT_STORE(0);
        __syncthreads();
        for (int kt = kt0; kt <= kt1; ++kt) {
            const int cur = (kt - kt0) & 1;
            if (kt < kt1) ATT_LOAD(kt + 1);
            if (kt * 64 <= qw + 31) {
                const lds_u8* sb = lds + cur * STG; const lds_u8* Kb = sb + map * 64 * RK; const lds_u8* Vb = sb + 128 * RK;
                f32x16 st[2];
                const float d0 = (float)(kt * 64 + 4 * hh - (qw + l31));
#pragma unroll
                for (int kb2 = 0; kb2 < 2; ++kb2)
#pragma unroll
                    for (int r = 0; r < 16; ++r) st[kb2][r] = slope2 * (d0 + (float)(kb2 * 32 + (r & 3) + 8 * (r >> 2)));
#pragma unroll
                for (int kb2 = 0; kb2 < 2; ++kb2)
#pragma unroll
                    for (int s = 0; s < 4; ++s) { const bf16x8 A = *(const LAS bf16x8*)(Kb + (kb2 * 32 + l31) * RK + (16 * s + 8 * hh) * 2); st[kb2] = MFMA32(A, qf[s], st[kb2]); }
                if (kt * 64 + 63 > qw) {
                    const int qrel = qw + l31 - kt * 64 - 4 * hh;
#pragma unroll
                    for (int kb2 = 0; kb2 < 2; ++kb2)
#pragma unroll
                        for (int r = 0; r < 16; ++r) if (kb2 * 32 + (r & 3) + 8 * (r >> 2) > qrel) st[kb2][r] = -1e30f;
                }
                float mt = st[0][0];
#pragma unroll
                for (int r = 1; r < 16; ++r) mt = fmaxf(mt, st[0][r]);
#pragma unroll
                for (int r = 0; r < 16; ++r) mt = fmaxf(mt, st[1][r]);
                mt = fmaxf(mt, __shfl_xor(mt, 32));
                const float mn = fmaxf(mrun, mt), alpha = ex2(mrun - mn); mrun = mn;
                float rs = 0.f;
#pragma unroll
                for (int kb2 = 0; kb2 < 2; ++kb2)
#pragma unroll
                    for (int r = 0; r < 16; ++r) { const float p = ex2(st[kb2][r] - mn); st[kb2][r] = p; rs += p; }
                lrun = lrun * alpha + rs;
#pragma unroll
                for (int db = 0; db < 4; ++db) o[db] *= alpha;
                bf16x8 pf[4];
#pragma unroll
                for (int ks = 0; ks < 4; ++ks) { const int kb2 = ks >> 1, r0 = (ks & 1) * 8; pf[ks] = pack8(st[kb2][r0], st[kb2][r0 + 1], st[kb2][r0 + 2], st[kb2][r0 + 3], st[kb2][r0 + 4], st[kb2][r0 + 5], st[kb2][r0 + 6], st[kb2][r0 + 7]); }
#pragma unroll
                for (int ks = 0; ks < 4; ++ks)
                {
#pragma unroll
                  for (int db = 0; db < 4; ++db) { const bf16x8 A = tr_frag(Vb + troffV + 16 * ks * RV + db * 64, 8 * RV); o[db] = MFMA32(A, pf[ks], o[db]); }
                }
            }
            if (kt < kt1) ATT_STORE(cur ^ 1);
            __syncthreads();
        }
#undef ATT_LOAD
#undef ATT_STORE
        lrun += __shfl_xor(lrun, 32);
        const float inv = 1.0f / lrun;
        LAS f32x4* Xs = (LAS f32x4*)lds;
        if (map == 1) {
#pragma unroll
            for (int db = 0; db < 4; ++db)
#pragma unroll
                for (int rq = 0; rq < 4; ++rq) Xs[(qs * 16 + db * 4 + rq) * 64 + lane] = (f32x4){o[db][4 * rq] * inv, o[db][4 * rq + 1] * inv, o[db][4 * rq + 2] * inv, o[db][4 * rq + 3] * inv};
        }
        __syncthreads();
        if (map == 0) {
            float ss = 0.f;
#pragma unroll
            for (int db = 0; db < 4; ++db)
#pragma unroll
                for (int rq = 0; rq < 4; ++rq) { const f32x4 x2 = Xs[(qs * 16 + db * 4 + rq) * 64 + lane];
#pragma unroll
                    for (int j = 0; j < 4; ++j) { const float d = o[db][4 * rq + j] * inv - lam * x2[j]; o[db][4 * rq + j] = d; ss += d * d; } }
            ss += __shfl_xor(ss, 32);
            const float rstd = (1.0f - lambda_init) / sqrtf(ss * (1.0f / 128.0f) + EPS);
            lds_u8* Os = lds + 65536 + qs * (32 * 272);
#pragma unroll
            for (int db = 0; db < 4; ++db)
#pragma unroll
                for (int rq = 0; rq < 4; ++rq) { const int dv = db * 32 + 8 * rq + 4 * hh; const f32x4 sg = *(const f32x4*)(a.in[I_SUBG] + layer * 128 + dv);
                    const v2u w = {pk2(o[db][4 * rq] * rstd * sg[0], o[db][4 * rq + 1] * rstd * sg[1]), pk2(o[db][4 * rq + 2] * rstd * sg[2], o[db][4 * rq + 3] * rstd * sg[3])};
                    *(LAS v2u*)(Os + l31 * 272 + dv * 2) = w; }
#pragma unroll
            for (int i = 0; i < 8; ++i) { const int cid = lane + 64 * i, row = cid >> 4, cc = cid & 15;
                *(v4u*)(ycat + (row0 + qw + row) * D + 2560 + hd * 128 + cc * 8) = *(const LAS v4u*)(Os + row * 272 + cc * 16); }
        }
    }
}
constexpr int N_PHASES = 1 + 9 * NLAYER;
#ifndef MK_ONE_LAUNCH
#define MK_ONE_LAUNCH 1
#endif
__global__ void __launch_bounds__(NWAVES * 64, 2) fwd_kernel(Args args) {
    extern __shared__ __attribute__((aligned(16))) unsigned char lds_raw[];
    lds_u8* lds = (lds_u8*)lds_raw;
    volatile LAS unsigned* MISC = (volatile LAS unsigned*)(lds + MISC_OFF);
    const int tid0 = threadIdx.x;
    const int G = gridDim.x, bx = blockIdx.x;
    const int vcu = (G % 8 == 0) ? (bx % 8) * (G / 8) + bx / 8 : bx;
    const int NGW = G * NWAVES;
    for (int u = tid0; u < (LDS_BYTES - LDSCTL_OFF) / 4; u += NWAVES * 64) ((LAS unsigned*)(lds + LDSCTL_OFF))[u] = 0u;
    __syncthreads();
    unsigned* ctl = (unsigned*)(args.ws + WS_CTL);
    XcdBarrier bar; bar.bar = ctl + CW_BAR; bar.x = 0; bar.st = nullptr;
    const int lo = args.ph_lo, hi = args.ph_hi;
    if (hi - lo > 1) bar = xcd_barrier_post(ctl + CW_BAR, MISC + 8);
#ifndef PROBE_DUP
#define PROBE_DUP 0
#endif
#define DUPN(j) ((((PROBE_DUP) >> (j)) & 1) ? 2 : 1)
#ifndef PH_MASK
#define PH_MASK 0xffff
#endif
#define IN(k) (lo <= (k) && (k) < hi)
#define HAS(j) (((PH_MASK) >> (j)) & 1)
#define SEAM(k) do { if (IN(k) && IN((k) + 1)) { XcdBarrier b2_ = bar; asm volatile("" : "+s"(b2_.bar), "+s"(b2_.x));     \
        xcd_barrier(b2_); } } while (0)
    unsigned char* ws = args.ws;
    bf16* XN = (bf16*)(ws + WS_XN); bf16* HID = (bf16*)(ws + WS_HID); bf16* MIXO = (bf16*)(ws + WS_MIXO); bf16* YPRE = (bf16*)(ws + WS_YPRE); bf16* YCAT = (bf16*)(ws + WS_YCAT); bf16* MERGED = (bf16*)(ws + WS_MERGED);

    float* SSQ = (float*)(ws + WS_SSQP);
    static_assert(M / 256 == 64 && pg8::WGM == 8 && pg8::NXCD == 8, "row_scales_phase: a workgroup's units stay inside 8 row panels only for 64 panels / 8 XCD chunks / 8-panel groups");
    const int PM0 = 8 * (bx % 8);
    LAS float* RSL = (LAS float*)(lds + LDSCTL_OFF + 1024);
    if (HAS(12) && IN(0)) { const int lane = tid0 & 63, wave = __builtin_amdgcn_readfirstlane(tid0 >> 6); for (int dup = 0; dup < DUPN(0); ++dup) conv_phase(args, lds, vcu * NWAVES + wave, NGW, lane, wave);
        for (int dup = 0; dup < DUPN(1); ++dup) norm_phase(args.in[I_X], args.in[I_NORMW], XN, vcu * NWAVES + wave, NGW, lane); }
    SEAM(0);
    for (int l = 0; l < NLAYER; ++l) {
        const int pb = 1 + 9 * l;
        int tid = tid0; asm volatile("" : "+v"(tid));
        const int lane = tid & 63, wave = __builtin_amdgcn_readfirstlane(tid >> 6);
        unsigned char* wl = ws + WS_W + (size_t)l * LW_SIZE;
        const float* hin = (l == 0) ? args.in[I_X] : args.out;
        const float* nw = args.in[I_NORMW] + (size_t)l * 3 * D;
        float* ssq1 = SSQ + (size_t)(l * 3 + 0) * M * 64; float* ssq2 = SSQ + (size_t)(l * 3 + 1) * M * 64; float* ssq3 = SSQ + (size_t)(l * 3 + 2) * M * 64;
        if (HAS(0) && IN(pb + 0)) { pg8::Gemm g{XN, (const bf16*)(wl + LW_FI0), M, 2 * FF, D}; pg8::StaticOrder S; S.init(M, 2 * FF, G, bx);
            const float* sq0 = l == 0 ? (const float*)nullptr : (const float*)(SSQ + (size_t)((l - 1) * 3 + 2) * M * 64); if (sq0) pg8::row_scales_phase(sq0, 1.0f / D, EPS, RSL, PM0, tid);
            pg8::EpiSwiglu E{HID, FF, sq0, 1.0f / D, EPS, RSL, PM0};
            for (int dup = 0; dup < DUPN(2); ++dup) { pg8::gemm_phase<pg8::EpiSwiglu, pg8::StaticOrder, true, true>(lds, g, S, E); } }
        SEAM(pb + 0);
        if (HAS(1) && IN(pb + 1)) { pg8::Gemm g{HID, (const bf16*)(wl + LW_FO0), M, D, FF}; pg8::StaticOrder S; S.init(M, D, G, bx); pg8::EpiResid E{hin, args.out, D, 0.5f, XN, nw + D, ssq1};
            if (DUPN(3) == 2) { pg8::EpiResid E2{hin, (float*)YCAT, D, 0.5f, XN, nw + D, ssq1}; pg8::gemm_phase<pg8::EpiResid, pg8::StaticOrder, true, true>(lds, g, S, E2); }
            pg8::gemm_phase<pg8::EpiResid, pg8::StaticOrder, true, true>(lds, g, S, E); }
        SEAM(pb + 1);
        if (HAS(2) && IN(pb + 2)) { pg8::Gemm g{XN, (const bf16*)(wl + LW_MIX), M, NIN, D}; pg8::StaticOrder S; S.init(M, NIN, G, bx); pg8::row_scales_phase(ssq1, 1.0f / D, EPS, RSL, PM0, tid); pg8::EpiMix E{MIXO, NIN, C_G / 256, ssq1, 1.0f / D, EPS, RSL, PM0};
            for (int dup = 0; dup < DUPN(4); ++dup) { pg8::gemm_phase<pg8::EpiMix, pg8::StaticOrder, true, true>(lds, g, S, E); } }
        SEAM(pb + 2);
        if (HAS(3) && IN(pb + 3)) {
            constexpr int NRS = NB * 6 * 2; const int nA = (G >= 2 * NRS) ? G - NRS : G;
            if (bx < nA) { if (HAS(13)) for (int dup = 0; dup < DUPN(5); ++dup) ssm_phase(args, l, lds, lane, wave, bx, nA); if (HAS(14)) qknorm_phase(args, l, bx * NWAVES + wave, nA * NWAVES, lane); }
            __syncthreads(); if (HAS(15)) for (int dup = 0; dup < DUPN(6); ++dup) ret_state_phase(args, lds, tid, lane, wave); }
        SEAM(pb + 3);
        if (HAS(4) && IN(pb + 4)) { if (HAS(13)) for (int dup = 0; dup < DUPN(7); ++dup) attn_phase(args, l, lds, tid, lane, wave); __syncthreads(); if (HAS(14)) for (int dup = 0; dup < DUPN(8); ++dup) ret_out_phase(args, lds, tid, lane, wave); __syncthreads();
            if (HAS(15)) { pg8::Gemm g{YPRE, (const bf16*)(wl + LW_GLU), M, 1024, 1024}; pg8::StaticOrder S; S.init(M, 1024, G, bx); pg8::EpiGlu E{YPRE, 1024, YCAT, D, args.in[I_GLUB] + (size_t)l * 1024};
            for (int dup = 0; dup < DUPN(9); ++dup) { pg8::gemm_phase<pg8::EpiGlu, pg8::StaticOrder, true, true>(lds, g, S, E); } } }
        SEAM(pb + 4);
        if (HAS(5) && IN(pb + 5)) { pg8::Gemm g{YCAT, (const bf16*)(wl + LW_BR), M, D, D}; pg8::StaticOrder S; S.init(M, D, G, bx); pg8::EpiBranch E{MIXO + C_G, NIN, MERGED, D};
            for (int dup = 0; dup < DUPN(10); ++dup) { pg8::gemm_phase<pg8::EpiBranch, pg8::StaticOrder, true, true>(lds, g, S, E); } }
        SEAM(pb + 5);
        if (HAS(6) && IN(pb + 6)) { pg8::Gemm g{MERGED, (const bf16*)(wl + LW_OUT), M, D, D}; pg8::StaticOrder S; S.init(M, D, G, bx); pg8::EpiResid E{args.out, args.out, D, 1.0f, XN, nw + 2 * D, ssq2};
            if (DUPN(11) == 2) { pg8::EpiResid E2{args.out, (float*)HID, D, 1.0f, XN, nw + 2 * D, ssq2}; pg8::gemm_phase<pg8::EpiResid, pg8::StaticOrder, true, true>(lds, g, S, E2); }
            pg8::gemm_phase<pg8::EpiResid, pg8::StaticOrder, true, true>(lds, g, S, E); }
        SEAM(pb + 6);
        if (HAS(7) && IN(pb + 7)) { pg8::Gemm g{XN, (const bf16*)(wl + LW_FI1), M, 2 * FF, D}; pg8::StaticOrder S; S.init(M, 2 * FF, G, bx); pg8::row_scales_phase(ssq2, 1.0f / D, EPS, RSL, PM0, tid); pg8::EpiSwiglu E{HID, FF, ssq2, 1.0f / D, EPS, RSL, PM0};
            for (int dup = 0; dup < DUPN(2); ++dup) { pg8::gemm_phase<pg8::EpiSwiglu, pg8::StaticOrder, true, true>(lds, g, S, E); } }
        SEAM(pb + 7);
        if (HAS(8) && IN(pb + 8)) { pg8::Gemm g{HID, (const bf16*)(wl + LW_FO1), M, D, FF}; pg8::StaticOrder S; S.init(M, D, G, bx);
            const bool more = (l + 1 < NLAYER); pg8::EpiResid E{args.out, args.out, D, 0.5f, more ? XN : (bf16*)nullptr, more ? nw + 3 * D : (const float*)nullptr, more ? ssq3 : (float*)nullptr};
            if (DUPN(3) == 2) { pg8::EpiResid E2{args.out, (float*)YCAT, D, 0.5f, more ? XN : (bf16*)nullptr, more ? nw + 3 * D : (const float*)nullptr, more ? ssq3 : (float*)nullptr}; pg8::gemm_phase<pg8::EpiResid, pg8::StaticOrder, true, true>(lds, g, S, E2); }
            pg8::gemm_phase<pg8::EpiResid, pg8::StaticOrder, true, true>(lds, g, S, E); }
        SEAM(pb + 8);
    }
#undef IN
#undef SEAM
}

extern "C" void kernel_launch(void* const* d_in, const int* in_sizes, int n_in, void* d_out, int out_size, void* d_ws, size_t ws_size, hipStream_t stream) {
    static int grid = 0;
    if (grid == 0) {
        if (n_in != 26 || in_sizes[0] != M * D || out_size != M * D || ws_size < WS_END) { fprintf(stderr, "kernel_launch: unexpected shapes (n_in %d, in0 %d, out %d, ws %zu < %zu); nothing launched\n", n_in, n_in > 0 ? in_sizes[0] : -1, out_size, ws_size, (size_t)WS_END); grid = -1; return; }
        int dev = 0, cus = 0, per_cu = 0;
        if (hipGetDevice(&dev) != hipSuccess || hipDeviceGetAttribute(&cus, hipDeviceAttributeMultiprocessorCount, dev) != hipSuccess) { grid = -1; return; }
        if (hipFuncSetAttribute((const void*)fwd_kernel, hipFuncAttributeMaxDynamicSharedMemorySize, LDS_BYTES) != hipSuccess) { fprintf(stderr, "kernel_launch: hipFuncSetAttribute failed\n"); grid = -1; return; }
        if (hipOccupancyMaxActiveBlocksPerMultiprocessor(&per_cu, (const void*)fwd_kernel, NWAVES * 64, LDS_BYTES) != hipSuccess || per_cu < 1) { fprintf(stderr, "kernel_launch: occupancy query says %d workgroups per CU\n", per_cu); }
        (void)hipGetLastError();
        grid = cus;
        if (grid % 8 != 0) { fprintf(stderr, "kernel_launch: %d CUs: this kernel's unit order needs a multiple of 8 workgroups; nothing launched\n", grid); grid = -1; return; }
    }
    if (grid < 0) return;
    if (hipMemsetAsync((char*)d_ws + WS_CTL, 0, CTL_ZERO_BYTES, stream) != hipSuccess) return;
    Args a{};
    for (int i = 0; i < 26; ++i) a.in[i] = (const float*)d_in[i];
    a.out = (float*)d_out; a.ws = (unsigned char*)d_ws;
#if MK_ONE_LAUNCH
    a.ph_lo = 0; a.ph_hi = N_PHASES;
    hipLaunchKernelGGL(fwd_kernel, dim3(grid), dim3(NWAVES * 64), LDS_BYTES, stream, a);
#else
    for (int p = 0; p < N_PHASES; ++p) { a.ph_lo = p; a.ph_hi = p + 1; hipLaunchKernelGGL(fwd_kernel, dim3(grid), dim3(NWAVES * 64), LDS_BYTES, stream, a); }
#endif
}
```

```cpp
#include <hip/hip_runtime.h>
#include <cstdio>
#include <cstdint>
namespace pg8 {
#define PG8_LAS __attribute__((address_space(3)))
typedef unsigned short bf16_t;
typedef short bf16x8 __attribute__((ext_vector_type(8)));
typedef float f32x4 __attribute__((ext_vector_type(4)));
typedef unsigned u32x4 __attribute__((ext_vector_type(4)));
constexpr int BM = 256, BK = 64, HALF = 128, HTB = HALF * BK * 2  , STAGE_BYTES = 8 * HTB, NXCD = 8, WGM = 8;

__host__ __device__ __forceinline__ int lds_byte(int r, int c) { const int st = (r >> 4) * 2 + (c >> 5), rr = r & 15, cc = c & 31, ob = rr * 64 + cc * 2; return st * 1024 + (ob ^ (((ob >> 9) & 1) << 5)); }
__host__ __device__ __forceinline__ void stage_rc(int b, int& R, int& C) { const int st = b / 1024, sb = b % 1024, swz = sb ^ (((sb >> 9) & 1) << 5); R = (st >> 1) * 16 + swz / 64; C = (st & 1) * 32 + (swz % 64) / 2; }
__host__ __device__ __forceinline__ int perm32(int rho) { const int n = rho >> 4, i = rho & 15; return 8 * (i >> 2) + 4 * n + (i & 3); }

struct Unit { int pm, pn; };
struct Gemm { const bf16_t* A; const bf16_t* Bt; int M, N, K; };

struct StaticOrder {
    int nM, nN, nwg, G, c, wgm;
    __host__ __device__ void init(int M, int N, int G_, int c_, int wgm_ = WGM) { nM = M / BM; nN = N / BM; nwg = nM * nN; G = G_; c = c_; wgm = wgm_; }
    __host__ __device__ bool next(int i, Unit& u) const {
        const long L = (long)i * G + c; if (L >= nwg) return false;
        int wgid = (int)L; { const int q = nwg / NXCD, r = nwg % NXCD, xcd = wgid % NXCD, off = wgid / NXCD; wgid = (xcd < r ? xcd * (q + 1) : r * (q + 1) + (xcd - r) * q) + off; }
        const int nig = wgm * nN, gid = wgid / nig, fm = gid * wgm, gsz = (nM - fm) < wgm ? (nM - fm) : wgm;
        u.pm = fm + ((wgid % nig) % gsz); u.pn = (wgid % nig) / gsz; return true;
    }
    __device__ __forceinline__ void a_ready(const Unit&) const {}
    __device__ __forceinline__ void done(const Unit&) const {}
};

typedef float f32x2_t __attribute__((ext_vector_type(2))); typedef __bf16 bf16x2_t __attribute__((ext_vector_type(2)));
__device__ __forceinline__ unsigned cvt_pk_bf16(float lo, float hi) { const f32x2_t v = {lo, hi}; const bf16x2_t b = __builtin_convertvector(v, bf16x2_t); return __builtin_bit_cast(unsigned, b); }
__host__ __device__ __forceinline__ size_t sub_off(size_t r, int c, int K) {
    return (((r >> 7) * (size_t)(K >> 6) + (size_t)(c >> 6)) << 14) + (((r >> 4) & 7) << 11) + (size_t)(((c >> 5) & 1) << 10) + ((r & 15) << 6) + (size_t)((c & 31) << 1); }
__device__ __forceinline__ float bf_lo(unsigned w) { return __uint_as_float(w << 16); }
__device__ __forceinline__ float bf_hi(unsigned w) { return __uint_as_float(w & 0xffff0000u); }
__device__ __forceinline__ float sigm(float v) { return __builtin_amdgcn_rcpf(1.0f + __builtin_amdgcn_exp2f(-1.4426950408889634f * v)); }


__device__ __forceinline__ void row_scales_phase(const float* ssq, float inv_d, float eps, PG8_LAS float* rsl, int pm0, int tid) {
    for (int row = tid; row < 8 * BM; row += 512) {
        const f32x4* sp = (const f32x4*)(ssq + ((size_t)pm0 * BM + row) * 64);
        f32x4 s4 = sp[0];
#pragma unroll
        for (int q = 1; q < 16; ++q) s4 += sp[q];
        rsl[row] = 1.0f / sqrtf(((s4[0] + s4[1]) + (s4[2] + s4[3])) * inv_d + eps);
    }
    __syncthreads();
}
struct EpiNull {
    static constexpr bool PERM = true, AFTER_DRAIN = false, MID = false; static constexpr int T0 = -1, T1 = -1;
    bf16_t* O;
    __device__ __forceinline__ void mid(f32x4 (&acc)[2][2][4][2], const Unit& u, int t, int wr, int wc, int fr, int fq) const {}
    __device__ __forceinline__ void operator()(const f32x4 (&acc)[2][2][4][2], const Unit& u, int wr, int wc, int fr, int fq) const {
        float s = 0.f;
#pragma unroll
        for (int ai = 0; ai < 2; ++ai)
#pragma unroll
            for (int bj = 0; bj < 2; ++bj)
#pragma unroll
                for (int m = 0; m < 4; ++m)
#pragma unroll
                    for (int n = 0; n < 2; ++n) s += (acc[ai][bj][m][n][0] + acc[ai][bj][m][n][1]) + (acc[ai][bj][m][n][2] + acc[ai][bj][m][n][3]);
        if (s == 1.2345e30f) O[0] = 1;
    }
};
struct EpiSwiglu {
    static constexpr bool PERM = true, AFTER_DRAIN = false, MID = false; static constexpr int T0 = -1, T1 = -1;
    bf16_t* O; int ldc; const float* ssq; float inv_d, eps; PG8_LAS float* rsl; int pm0;
    __device__ __forceinline__ void mid(f32x4 (&acc)[2][2][4][2], const Unit& u, int t, int wr, int wc, int fr, int fq) const {}
    __device__ __forceinline__ void operator()(const f32x4 (&acc)[2][2][4][2], const Unit& u, int wr, int wc, int fr, int fq) const {
        const int row0 = u.pm * BM + wr * 64 + fr, col0 = u.pn * HALF + wc * 32 + 8 * fq;
#pragma unroll
        for (int ai = 0; ai < 2; ++ai)
#pragma unroll
            for (int m = 0; m < 4; ++m) { bf16_t* rowp = (bf16_t*)((char*)O + sub_off((size_t)(row0 + ai * HALF + m * 16), col0, ldc));
                float h[8]; const float rs = ssq ? rsl[(u.pm - pm0) * BM + wr * 64 + ai * HALF + m * 16 + fr] : 1.0f;
#pragma unroll
                for (int n = 0; n < 2; ++n)
#pragma unroll
                    for (int j = 0; j < 4; ++j) { const float g = acc[ai][0][m][n][j] * rs, up = acc[ai][1][m][n][j] * rs; h[n * 4 + j] = g * sigm(g) * up; }
                u32x4 w; w.x = cvt_pk_bf16(h[0], h[1]); w.y = cvt_pk_bf16(h[2], h[3]); w.z = cvt_pk_bf16(h[4], h[5]); w.w = cvt_pk_bf16(h[6], h[7]);
                *(u32x4*)rowp = w; }
    }
};
template <bool BASE_F32, bool OUT_F32> struct EpiResid {
    static constexpr bool PERM = true, AFTER_DRAIN = false, MID = false; static constexpr int T0 = -1, T1 = -1;
    const void* base; void* out; int ldc; float scale; float* ssq;
    __device__ __forceinline__ void mid(f32x4 (&acc)[2][2][4][2], const Unit& u, int t, int wr, int wc, int fr, int fq) const {}
    __device__ __forceinline__ void operator()(const f32x4 (&acc)[2][2][4][2], const Unit& u, int wr, int wc, int fr, int fq) const {
        const int row0 = u.pm * BM + wr * 64 + fr, col0 = u.pn * BM + wc * 32 + 8 * fq;
#pragma unroll
        for (int ai = 0; ai < 2; ++ai)
#pragma unroll
            for (int m = 0; m < 4; ++m) { const size_t off = (size_t)(row0 + ai * HALF + m * 16) * ldc + col0; float ss = 0.f;
                const size_t so = sub_off((size_t)(row0 + ai * HALF + m * 16), col0, ldc);
#pragma unroll
                for (int bj = 0; bj < 2; ++bj) { f32x4 b0, b1;
                    if (BASE_F32) { b0 = *(const f32x4*)((const float*)base + off + bj * HALF); b1 = *(const f32x4*)((const float*)base + off + bj * HALF + 4); }
                    else { const u32x4 w = *(const u32x4*)((const char*)base + so + bj * 32768); b0 = (f32x4){bf_lo(w.x), bf_hi(w.x), bf_lo(w.y), bf_hi(w.y)}; b1 = (f32x4){bf_lo(w.z), bf_hi(w.z), bf_lo(w.w), bf_hi(w.w)}; }
                    const f32x4 o0 = b0 + scale * acc[ai][bj][m][0], o1 = b1 + scale * acc[ai][bj][m][1];
                    if (OUT_F32) { *(f32x4*)((float*)out + off + bj * HALF) = o0; *(f32x4*)((float*)out + off + bj * HALF + 4) = o1; }
                    else { ss += ((o0[0] * o0[0] + o0[1] * o0[1]) + (o0[2] * o0[2] + o0[3] * o0[3])) + ((o1[0] * o1[0] + o1[1] * o1[1]) + (o1[2] * o1[2] + o1[3] * o1[3]));
                        u32x4 w; w.x = cvt_pk_bf16(o0[0], o0[1]); w.y = cvt_pk_bf16(o0[2], o0[3]); w.z = cvt_pk_bf16(o1[0], o1[1]); w.w = cvt_pk_bf16(o1[2], o1[3]);
                        *(u32x4*)((char*)out + so + bj * 32768) = w; } }
                if (!OUT_F32) { ss += __shfl_xor(ss, 16); ss += __shfl_xor(ss, 32); if (fq == 0) ssq[(size_t)(row0 + ai * HALF + m * 16) * 64 + u.pn * 4 + wc] = ss; }
                if (m == 3) asm volatile("" ::: "memory"); }
    }
};
struct EpiMix {
    static constexpr bool PERM = true, AFTER_DRAIN = false, MID = false; static constexpr int T0 = -1, T1 = -1;
    bf16_t* O; int ldc; int gate_pn; const float* ssq; float inv_d, eps; PG8_LAS float* rsl; int pm0;
    const float* qg; const float* kg; PG8_LAS float* xs; int q_pn, k_pn, v_pn;
    __device__ __forceinline__ void mid(f32x4 (&acc)[2][2][4][2], const Unit& u, int t, int wr, int wc, int fr, int fq) const {}
    __device__ __forceinline__ void qk_tile(const f32x4 (&acc)[2][2][4][2], const Unit& u, int wr, int wc, int fr, int fq) const {
        const int row0 = u.pm * BM + wr * 64 + fr, col0 = u.pn * BM + wc * 32 + 8 * fq; const bool isq = u.pn < k_pn; const int wv = wr * 4 + wc;
        const float* gp = (isq ? qg : kg) + 32 * (wc & 1) + 8 * fq; const float gsc = isq ? 0.125f * 1.4426950408889634f : 1.0f;
        const f32x4 g0 = *(const f32x4*)gp * gsc, g1 = *(const f32x4*)(gp + 4) * gsc;
#pragma unroll
        for (int ai = 0; ai < 2; ++ai)
#pragma unroll
            for (int m = 0; m < 4; ++m) { const float rs = rsl[(u.pm - pm0) * BM + wr * 64 + ai * HALF + m * 16 + fr];
#pragma unroll
                for (int bj = 0; bj < 2; ++bj) { const f32x4 v0 = acc[ai][bj][m][0] * rs, v1 = acc[ai][bj][m][1] * rs;
                    float s = v0[0] * v0[0] + v0[1] * v0[1] + v0[2] * v0[2] + v0[3] * v0[3] + v1[0] * v1[0] + v1[1] * v1[1] + v1[2] * v1[2] + v1[3] * v1[3];
                    s += __shfl_xor(s, 16); s += __shfl_xor(s, 32);
                    if (fq == 0) xs[(wv * 16 + (ai * 4 + m) * 2 + bj) * 16 + fr] = s; } }
        asm volatile("s_waitcnt lgkmcnt(0)" ::: "memory"); __builtin_amdgcn_s_barrier(); asm volatile("" ::: "memory");
#pragma unroll
        for (int ai = 0; ai < 2; ++ai)
#pragma unroll
            for (int m = 0; m < 4; ++m) { bf16_t* rowp = O + (size_t)(row0 + ai * HALF + m * 16) * ldc + col0; const float rs = rsl[(u.pm - pm0) * BM + wr * 64 + ai * HALF + m * 16 + fr];
#pragma unroll
                for (int bj = 0; bj < 2; ++bj) { const int ix = ((ai * 4 + m) * 2 + bj) * 16 + fr;
                    const float r = rs * __builtin_amdgcn_rsqf((xs[wv * 256 + ix] + xs[(wv ^ 1) * 256 + ix]) * (1.0f / 64.0f) + eps);
                    const f32x4 v0 = acc[ai][bj][m][0] * r * g0, v1 = acc[ai][bj][m][1] * r * g1;
                    u32x4 w; w.x = cvt_pk_bf16(v0[0], v0[1]); w.y = cvt_pk_bf16(v0[2], v0[3]); w.z = cvt_pk_bf16(v1[0], v1[1]); w.w = cvt_pk_bf16(v1[2], v1[3]);
                    *(u32x4*)(rowp + bj * HALF) = w; } }
    }
    __device__ __forceinline__ void operator()(const f32x4 (&acc)[2][2][4][2], const Unit& u, int wr, int wc, int fr, int fq) const {
        if (u.pn >= q_pn && u.pn < v_pn) { qk_tile(acc, u, wr, wc, fr, fq); return; }
        const int row0 = u.pm * BM + wr * 64 + fr, col0 = u.pn * BM + wc * 32 + 8 * fq; const bool gate = u.pn >= gate_pn;
#pragma unroll
        for (int ai = 0; ai < 2; ++ai)
#pragma unroll
            for (int m = 0; m < 4; ++m) { bf16_t* rowp = O + (size_t)(row0 + ai * HALF + m * 16) * ldc + col0; const float rs = rsl[(u.pm - pm0) * BM + wr * 64 + ai * HALF + m * 16 + fr];
#pragma unroll
                for (int bj = 0; bj < 2; ++bj) { f32x4 v0 = acc[ai][bj][m][0] * rs, v1 = acc[ai][bj][m][1] * rs;
                    if (gate) {
#pragma unroll
                        for (int j = 0; j < 4; ++j) { v0[j] = sigm(fminf(fmaxf(v0[j], -30.f), 30.f)); v1[j] = sigm(fminf(fmaxf(v1[j], -30.f), 30.f)); } }
                    u32x4 w; w.x = cvt_pk_bf16(v0[0], v0[1]); w.y = cvt_pk_bf16(v0[2], v0[3]); w.z = cvt_pk_bf16(v1[0], v1[1]); w.w = cvt_pk_bf16(v1[2], v1[3]);
                    *(u32x4*)(rowp + bj * HALF) = w; } }
    }
};
struct EpiGlu {
    static constexpr bool PERM = true, AFTER_DRAIN = false, MID = false; static constexpr int T0 = -1, T1 = -1;
    const bf16_t* Y; int ldy; bf16_t* O; int ldo; const float* bias;
    __device__ __forceinline__ void mid(f32x4 (&acc)[2][2][4][2], const Unit& u, int t, int wr, int wc, int fr, int fq) const {}
    __device__ __forceinline__ void operator()(const f32x4 (&acc)[2][2][4][2], const Unit& u, int wr, int wc, int fr, int fq) const {
        const int row0 = u.pm * BM + wr * 64 + fr, col0 = u.pn * BM + wc * 32 + 8 * fq;
#pragma unroll
        for (int bj = 0; bj < 2; ++bj) { const f32x4 b0 = *(const f32x4*)(bias + col0 + bj * HALF), b1 = *(const f32x4*)(bias + col0 + bj * HALF + 4);
#pragma unroll
            for (int ai = 0; ai < 2; ++ai)
#pragma unroll
                for (int m = 0; m < 4; ++m) { const int r = row0 + ai * HALF + m * 16;
                    const u32x4 y = *(const u32x4*)((const char*)Y + sub_off((size_t)r, col0 + bj * HALF, ldy));
                    const f32x4 v0 = acc[ai][bj][m][0] + b0, v1 = acc[ai][bj][m][1] + b1;
                    u32x4 w; w.x = cvt_pk_bf16(bf_lo(y.x) * sigm(v0[0]), bf_hi(y.x) * sigm(v0[1])); w.y = cvt_pk_bf16(bf_lo(y.y) * sigm(v0[2]), bf_hi(y.y) * sigm(v0[3]));
                    w.z = cvt_pk_bf16(bf_lo(y.z) * sigm(v1[0]), bf_hi(y.z) * sigm(v1[1])); w.w = cvt_pk_bf16(bf_lo(y.w) * sigm(v1[2]), bf_hi(y.w) * sigm(v1[3]));
                    *(u32x4*)((char*)O + sub_off((size_t)r, col0 + bj * HALF, ldo)) = w; } }
    }
};
struct EpiBranch {
    static constexpr bool PERM = true, AFTER_DRAIN = false, MID = true; static constexpr int T0 = 16, T1 = 40;
    const bf16_t* G; int ldg; bf16_t* O; int ldo;
    __device__ __forceinline__ void mid(f32x4 (&acc)[2][2][4][2], const Unit& u, int t, int wr, int wc, int fr, int fq) const {
        int fr_l = fr, fq_l = fq; asm volatile("" : "+v"(fr_l), "+v"(fq_l));
        const int row0 = u.pm * BM + wr * 64 + fr_l, col0 = u.pn * BM + wc * 32 + 8 * fq_l; const int ga = (t == T0) ? 0 : 4096;
#pragma unroll
        for (int ai = 0; ai < 2; ++ai)
#pragma unroll
            for (int m = 0; m < 4; ++m) { const bf16_t* gp = G + (size_t)(row0 + ai * HALF + m * 16) * ldg + col0 + ga;
#pragma unroll
                for (int bj = 0; bj < 2; ++bj) { const u32x4 a = *(const u32x4*)(gp + bj * HALF), b = *(const u32x4*)(gp + bj * HALF + 4096);
                    f32x4 r0, r1;
                    r0[0] = bf_lo(a.x) * __builtin_amdgcn_rcpf(bf_lo(b.x)); r0[1] = bf_hi(a.x) * __builtin_amdgcn_rcpf(bf_hi(b.x)); r0[2] = bf_lo(a.y) * __builtin_amdgcn_rcpf(bf_lo(b.y)); r0[3] = bf_hi(a.y) * __builtin_amdgcn_rcpf(bf_hi(b.y));
                    r1[0] = bf_lo(a.z) * __builtin_amdgcn_rcpf(bf_lo(b.z)); r1[1] = bf_hi(a.z) * __builtin_amdgcn_rcpf(bf_hi(b.z)); r1[2] = bf_lo(a.w) * __builtin_amdgcn_rcpf(bf_lo(b.w)); r1[3] = bf_hi(a.w) * __builtin_amdgcn_rcpf(bf_hi(b.w));
                    acc[ai][bj][m][0] *= r0; acc[ai][bj][m][1] *= r1; }
                asm volatile("" ::: "memory"); }
    }
    __device__ __forceinline__ void operator()(const f32x4 (&acc)[2][2][4][2], const Unit& u, int wr, int wc, int fr, int fq) const {
        const int row0 = u.pm * BM + wr * 64 + fr, col0 = u.pn * BM + wc * 32 + 8 * fq;
#pragma unroll
        for (int ai = 0; ai < 2; ++ai)
#pragma unroll
            for (int m = 0; m < 4; ++m) { const int r = row0 + ai * HALF + m * 16;
#pragma unroll
                for (int bj = 0; bj < 2; ++bj) { const u32x4 g = *(const u32x4*)(G + (size_t)r * ldg + col0 + bj * HALF + 8192);
                    const f32x4 v0 = acc[ai][bj][m][0], v1 = acc[ai][bj][m][1];
                    u32x4 w; w.x = cvt_pk_bf16(v0[0] * bf_lo(g.x), v0[1] * bf_hi(g.x)); w.y = cvt_pk_bf16(v0[2] * bf_lo(g.y), v0[3] * bf_hi(g.y));
                    w.z = cvt_pk_bf16(v1[0] * bf_lo(g.z), v1[1] * bf_hi(g.z)); w.w = cvt_pk_bf16(v1[2] * bf_lo(g.w), v1[3] * bf_hi(g.w));
                    *(u32x4*)((char*)O + sub_off((size_t)r, col0 + bj * HALF, ldo)) = w; }
                asm volatile("" ::: "memory"); }
    }
};
template <class Epi, class Sched, bool ALIGN_EPI = false, bool SP2 = false>
__device__ __forceinline__ void gemm_phase(PG8_LAS unsigned char* lds, const Gemm g, const Sched& S, const Epi& E, int wave_s  ) {
    int tid_l; asm volatile("v_mbcnt_lo_u32_b32 %0, -1, 0\n\tv_mbcnt_hi_u32_b32 %0, -1, %0" : "=v"(tid_l)); tid_l += wave_s * 64;
    const int tid = tid_l, wid = __builtin_amdgcn_readfirstlane(tid >> 6), lane = tid & 63, wr = wid >> 2, wc = wid & 3, fr = lane & 15, fq = lane >> 4;
    const int K = g.K, nt = K / BK;
    static_assert(Epi::PERM, "the converted weights are stored in LDS-slot (perm32) row order: every epilogue must use the PERM column map");
    unsigned voffA[2], voffB[2];
#pragma unroll
    for (int i = 0; i < 2; ++i) { int R, C; stage_rc(tid * 16 + i * 8192, R, C); const int Rb = Epi::PERM ? ((R & ~31) + perm32(R & 31)) : R;
        (void)Rb; voffB[i] = (unsigned)((R >> 4) * 2048 + (C >> 5) * 1024 + (R & 15) * 64 + (C & 31) * 2); voffA[i] = voffB[i]; }
    const size_t kstep = 16384;
    const size_t kstepB = kstep;
    const size_t hstep = (size_t)HALF * K * 2;
    const size_t tstep = 2 * hstep;
    const unsigned ldsw = (unsigned)wid * 1024u;
    const int aoff = lds_byte(wr * 64 + fr, fq * 8), boff = lds_byte(wc * 32 + fr, fq * 8);
#define PG8_SA(b, h) (((b) * 2 + (h)) * HTB)
#define PG8_SB(b, h) ((4 + (b) * 2 + (h)) * HTB)
#define PG8_STAGE(bufoff, gbase, voff) do { _Pragma("unroll") for (int _i = 0; _i < 2; ++_i) \
        __builtin_amdgcn_global_load_lds((const unsigned*)((const char*)(gbase) + (voff)[_i]), (PG8_LAS unsigned*)(lds + (bufoff) + ldsw + _i * 8192), 16, 0, 0); } while (0)
#define PG8_LDA(dst, b, h) do { _Pragma("unroll") for (int m = 0; m < 4; ++m) _Pragma("unroll") for (int k = 0; k < 2; ++k) dst[m][k] = *(const PG8_LAS bf16x8*)(lds + PG8_SA(b, h) + aoff + m * 2048 + k * 1024); } while (0)
#define PG8_LDB(dst, b, h) do { _Pragma("unroll") for (int n = 0; n < 2; ++n) _Pragma("unroll") for (int k = 0; k < 2; ++k) dst[n][k] = *(const PG8_LAS bf16x8*)(lds + PG8_SB(b, h) + boff + n * 2048 + k * 1024); } while (0)
#define PG8_MMA(ai, bj, At, Bt) do { __builtin_amdgcn_s_setprio(1); _Pragma("unroll") for (int m = 0; m < 4; ++m) _Pragma("unroll") for (int n = 0; n < 2; ++n) _Pragma("unroll") for (int k = 0; k < 2; ++k) \
        acc[ai][bj][m][n] = __builtin_amdgcn_mfma_f32_16x16x32_bf16(Bt[n][k], At[m][k], acc[ai][bj][m][n], 0, 0, 0); __builtin_amdgcn_s_setprio(0); } while (0)
#define PG8_WAIT_V(n) asm volatile("s_waitcnt vmcnt(" #n ")" ::: "memory")
#define PG8_WAIT_L(n) asm volatile("s_waitcnt lgkmcnt(" #n ")" ::: "memory")
#define PG8_BAR __builtin_amdgcn_s_barrier()
#define PG8_SCHED __builtin_amdgcn_sched_barrier(0)
    Unit cur, nxt; int ui = 0;
    if (!S.next(0, cur)) return;
    f32x4 acc[2][2][4][2];
#pragma unroll
    for (int a = 0; a < 2; ++a)
#pragma unroll
        for (int b = 0; b < 2; ++b)
#pragma unroll
            for (int m = 0; m < 4; ++m)
#pragma unroll
                for (int n = 0; n < 2; ++n) acc[a][b][m][n] = (f32x4){0.f, 0.f, 0.f, 0.f};
    bf16x8 At[4][2], B0[2][2], B1[2][2];
    const char* cA = (const char*)g.A + (size_t)cur.pm * tstep; const char* cB = (const char*)g.Bt + (size_t)cur.pn * tstep;
    S.a_ready(cur);
    if constexpr (SP2) {
        PG8_STAGE(PG8_SB(0, 0), cB, voffB); PG8_STAGE(PG8_SB(0, 1), cB + hstep, voffB); PG8_STAGE(PG8_SA(0, 0), cA, voffA); PG8_STAGE(PG8_SA(0, 1), cA + hstep, voffA);
        if (wr == 1) PG8_BAR;
        PG8_WAIT_V(2); PG8_BAR;
        PG8_STAGE(PG8_SB(1, 0), cB + kstepB, voffB); PG8_STAGE(PG8_SA(1, 0), cA + kstep, voffA); PG8_STAGE(PG8_SB(1, 1), cB + hstep + kstepB, voffB);
        PG8_WAIT_V(6); PG8_BAR;
    } else {
        PG8_STAGE(PG8_SB(0, 0), cB, voffB); PG8_STAGE(PG8_SA(0, 0), cA, voffA); PG8_STAGE(PG8_SB(0, 1), cB + hstep, voffB); PG8_STAGE(PG8_SA(0, 1), cA + hstep, voffA);
        if (wr == 1) PG8_BAR;
        PG8_WAIT_V(4); PG8_BAR;
        PG8_STAGE(PG8_SB(1, 0), cB + kstepB, voffB); PG8_STAGE(PG8_SA(1, 0), cA + kstep, voffA); PG8_STAGE(PG8_SB(1, 1), cB + hstep + kstepB, voffB);
        PG8_WAIT_V(6); PG8_BAR;
    }
    for (;;) {
        const bool has_next = S.next(ui + 1, nxt);
        const char* nA = has_next ? (const char*)g.A + (size_t)nxt.pm * tstep : cA; const char* nB = has_next ? (const char*)g.Bt + (size_t)nxt.pn * tstep : cB;
        for (int t = 0; t < nt; t += 2) {
            const bool last = (t == nt - 2);
            const char* a1 = cA + (size_t)(t + 1) * kstep;
            const char* a2 = last ? nA : cA + (size_t)(t + 2) * kstep; const char* b2 = last ? nB : cB + (size_t)(t + 2) * kstepB;
            const char* a3 = a2 + kstep; const char* b3 = b2 + kstepB;
            if (last && has_next) S.a_ready(nxt);
            if constexpr (Epi::MID) { if (t == Epi::T0 || t == Epi::T1) E.mid(acc, cur, t, wr, wc, fr, fq); }
            if constexpr (SP2) {
            PG8_LDB(B0, 0, 0); PG8_LDB(B1, 0, 1); PG8_SCHED; PG8_LDA(At, 0, 0); PG8_STAGE(PG8_SA(1, 1), a1 + hstep, voffA);
            PG8_WAIT_V(8); PG8_WAIT_L(0); PG8_BAR; PG8_MMA(0, 0, At, B0); PG8_MMA(0, 1, At, B1); PG8_BAR; PG8_SCHED;
            PG8_LDA(At, 0, 1); PG8_STAGE(PG8_SB(0, 0), b2, voffB); PG8_STAGE(PG8_SB(0, 1), b2 + hstep, voffB); PG8_STAGE(PG8_SA(0, 0), a2, voffA);
            PG8_WAIT_V(8); PG8_WAIT_L(0); PG8_BAR; PG8_MMA(1, 0, At, B0); PG8_MMA(1, 1, At, B1); PG8_BAR; PG8_SCHED;
            PG8_LDB(B0, 1, 0); PG8_LDB(B1, 1, 1); PG8_SCHED; PG8_LDA(At, 1, 0); PG8_STAGE(PG8_SA(0, 1), a2 + hstep, voffA);
            PG8_WAIT_V(8); PG8_WAIT_L(0); PG8_BAR; PG8_MMA(0, 0, At, B0); PG8_MMA(0, 1, At, B1); PG8_BAR; PG8_SCHED;
            PG8_LDA(At, 1, 1); PG8_STAGE(PG8_SB(1, 0), b3, voffB); PG8_STAGE(PG8_SB(1, 1), b3 + hstep, voffB); PG8_STAGE(PG8_SA(1, 0), a3, voffA);
            PG8_WAIT_V(8); PG8_WAIT_L(0); PG8_BAR; PG8_MMA(1, 0, At, B0); PG8_MMA(1, 1, At, B1); PG8_BAR; PG8_SCHED;
            } else {
            PG8_LDB(B0, 0, 0); PG8_SCHED; PG8_LDA(At, 0, 0); PG8_STAGE(PG8_SA(1, 1), a1 + hstep, voffA);
            PG8_WAIT_L(8); PG8_BAR; PG8_WAIT_L(0); PG8_MMA(0, 0, At, B0); PG8_BAR; PG8_SCHED;
            PG8_LDB(B1, 0, 1); PG8_STAGE(PG8_SB(0, 0), b2, voffB);
            PG8_BAR; PG8_WAIT_L(0); PG8_MMA(0, 1, At, B1); PG8_BAR;
            PG8_LDA(At, 0, 1); PG8_STAGE(PG8_SA(0, 0), a2, voffA);
            PG8_BAR; PG8_WAIT_L(0); PG8_MMA(1, 0, At, B0); PG8_BAR; PG8_SCHED;
            PG8_STAGE(PG8_SB(0, 1), b2 + hstep, voffB);
            PG8_WAIT_V(6); PG8_BAR; PG8_MMA(1, 1, At, B1); PG8_BAR;
            PG8_LDB(B0, 1, 0); PG8_SCHED; PG8_LDA(At, 1, 0); PG8_STAGE(PG8_SA(0, 1), a2 + hstep, voffA);
            PG8_WAIT_L(8); PG8_BAR; PG8_WAIT_L(0); PG8_MMA(0, 0, At, B0); PG8_BAR; PG8_SCHED;
            PG8_LDB(B1, 1, 1); PG8_STAGE(PG8_SB(1, 0), b3, voffB);
            PG8_BAR; PG8_WAIT_L(0); PG8_MMA(0, 1, At, B1); PG8_BAR;
            PG8_LDA(At, 1, 1); PG8_STAGE(PG8_SA(1, 0), a3, voffA);
            PG8_BAR; PG8_WAIT_L(0); PG8_MMA(1, 0, At, B0); PG8_BAR; PG8_SCHED;
            PG8_STAGE(PG8_SB(1, 1), b3 + hstep, voffB);
            PG8_WAIT_V(6); PG8_BAR; PG8_MMA(1, 1, At, B1); PG8_BAR;
            }
        }
        if constexpr (ALIGN_EPI) { if (wr == 0) PG8_BAR; }
        if constexpr (!Epi::AFTER_DRAIN) { E(acc, cur, wr, wc, fr, fq); S.done(cur); }
        if (!has_next) break;
#pragma unroll
        for (int a = 0; a < 2; ++a)
#pragma unroll
            for (int b = 0; b < 2; ++b)
#pragma unroll
                for (int m = 0; m < 4; ++m)
#pragma unroll
                    for (int n = 0; n < 2; ++n) acc[a][b][m][n] = (f32x4){0.f, 0.f, 0.f, 0.f};
        cur = nxt; cA = nA; cB = nB; ++ui;
        if constexpr (ALIGN_EPI) { if (wr == 1) PG8_BAR; }
    }
    PG8_WAIT_V(0);
    if constexpr (!ALIGN_EPI) { if (wr == 0) PG8_BAR; }
    PG8_BAR;
    if constexpr (Epi::AFTER_DRAIN) { E.fused(acc, cur, wr, wc, fr, fq, lds, wid, lane); S.done(cur); }
#undef PG8_SA
#undef PG8_SB
#undef PG8_STAGE
#undef PG8_LDA
#undef PG8_LDB
#undef PG8_MMA
#undef PG8_WAIT_V
#undef PG8_WAIT_L
#undef PG8_BAR
#undef PG8_SCHED
}
}

#define GAS __attribute__((address_space(1)))
#define LAS __attribute__((address_space(3)))
typedef unsigned short bf16;
typedef unsigned v4u __attribute__((ext_vector_type(4)));
typedef unsigned v2u __attribute__((ext_vector_type(2)));
typedef float f32x4 __attribute__((ext_vector_type(4)));
typedef float f32x16 __attribute__((ext_vector_type(16)));
typedef float f32x2v __attribute__((ext_vector_type(2)));
typedef short bf16x8 __attribute__((ext_vector_type(8)));
typedef short v4i16_t __attribute__((ext_vector_type(4)));
typedef GAS unsigned gu32;
#define RLX_AGENT __ATOMIC_RELAXED, __HIP_MEMORY_SCOPE_AGENT
#define LDS_WAIT() asm volatile("s_waitcnt lgkmcnt(0)" ::: "memory")
#define VM_WAIT() asm volatile("s_waitcnt vmcnt(0)" ::: "memory")
__device__ __forceinline__ unsigned pk2(float lo, float hi) { return pg8::cvt_pk_bf16(lo, hi); }
__device__ __forceinline__ float bflo(unsigned w) { return __uint_as_float(w << 16); }
__device__ __forceinline__ float bfhi(unsigned w) { return __uint_as_float(w & 0xffff0000u); }
__device__ __forceinline__ float ex2(float x) { return __builtin_amdgcn_exp2f(x); }
__device__ __forceinline__ float sigm(float v) { return __builtin_amdgcn_rcpf(1.0f + __builtin_amdgcn_exp2f(-1.4426950408889634f * v)); }

#define XB_TMO      128
#define XB_XCNT(j)  (256  + 64 * (j))
#define XB_XSUB(j)  (1280 + 64 * (j))
#define XB_XGEN(j)  (2304 + 64 * (j))
#define XB_TOP      3328
#define XB_TOPGEN   3392
#define XCD_BAR_WORDS 3456
#define XB_SPIN_CAP (1u << 18)

__device__ __forceinline__ unsigned xb_ld(unsigned* p)              { return __hip_atomic_load(p, __ATOMIC_RELAXED, __HIP_MEMORY_SCOPE_AGENT); }
__device__ __forceinline__ unsigned xb_add(unsigned* p, unsigned v) { return __hip_atomic_fetch_add(p, v, __ATOMIC_RELAXED, __HIP_MEMORY_SCOPE_AGENT); }
__device__ __forceinline__ unsigned xb_xcc_id() { return (unsigned)__builtin_amdgcn_s_getreg((3 << 11) | 20) & 0xFu; }
#define XB_SPIN(cond, bar) do { unsigned _sp = 0; while (cond) { __builtin_amdgcn_s_sleep(1); \
    if ((++_sp & 255u) == 0u) { if (xb_ld(&(bar)[XB_TMO])) break; if (_sp > XB_SPIN_CAP) { atomicAdd(&(bar)[XB_TMO], 1u); break; } } } } while (0)

struct XcdBarrier {
    unsigned* bar; unsigned x;
    volatile LAS unsigned* st;
};

__device__ __forceinline__ XcdBarrier xcd_barrier_post(unsigned* bar, volatile LAS unsigned* st) {
    XcdBarrier b; b.bar = bar; b.x = xb_xcc_id(); b.st = st;
    if (threadIdx.x == 0) (void)xb_add(&bar[XB_XCNT(b.x)], 1u);
    return b;
}
__device__ __forceinline__ void xcd_barrier_complete(unsigned* bar, unsigned x, unsigned& nloc, unsigned& nx) {
    const unsigned G = gridDim.x * gridDim.y * gridDim.z;
    unsigned sum, cnt, mine, sp = 0u;
    for (;;) {
        sum = 0u; cnt = 0u; mine = 0u;
#pragma unroll
        for (unsigned j = 0; j < 16; ++j) { const unsigned c = xb_ld(&bar[XB_XCNT(j)]); sum += c; cnt += (c > 0u) ? 1u : 0u; mine = (j == x) ? c : mine; }
        if (sum == G) break;
        __builtin_amdgcn_s_sleep(1);
        if ((++sp & 255u) == 0u) { if (xb_ld(&bar[XB_TMO])) break; if (sp > XB_SPIN_CAP) { atomicAdd(&bar[XB_TMO], 1u); break; } }
    }
    nloc = mine > 0u ? mine : 1u; nx = cnt > 0u ? cnt : 1u;
}

__device__ __forceinline__ void xcd_barrier(const XcdBarrier& b) {
    asm volatile("s_waitcnt vmcnt(0)" ::: "memory");
    __syncthreads();
    if (threadIdx.x == 0) {
        unsigned* bar = b.bar;
        __builtin_amdgcn_s_waitcnt(0);
        unsigned nloc = b.st[0], nx = b.st[1];
        if (nloc == 0u) { xcd_barrier_complete(bar, b.x, nloc, nx); b.st[0] = nloc; b.st[1] = nx; }
        const unsigned old = xb_add(&bar[XB_XSUB(b.x)], 1u);
        const unsigned gen = old / nloc;
        if (old + 1u == (gen + 1u) * nloc) {
            __builtin_amdgcn_fence(__ATOMIC_RELEASE, "agent");
            asm volatile("s_waitcnt vmcnt(0)" ::: "memory");
            const unsigned og = xb_add(&bar[XB_TOP], 1u);
            const unsigned tg = og / nx;
            if (og + 1u == (tg + 1u) * nx) xb_add(&bar[XB_TOPGEN], 1u);
            else XB_SPIN(xb_ld(&bar[XB_TOPGEN]) == tg, bar);
            __builtin_amdgcn_fence(__ATOMIC_ACQUIRE, "agent");
            xb_add(&bar[XB_XGEN(b.x)], 1u);
            asm volatile("s_waitcnt vmcnt(0)" ::: "memory");
        } else {
            XB_SPIN(xb_ld(&bar[XB_XGEN(b.x)]) == gen, bar);
            __builtin_amdgcn_fence(__ATOMIC_ACQUIRE, "agent");
            asm volatile("s_waitcnt vmcnt(0)" ::: "memory");
        }
    }
    __syncthreads();
}


constexpr int NB = 4, SEQ = 4096, D = 4096, M = NB * SEQ, FF = 11008, NIN = 22528, NLAYER = 2, NWAVES = 8;
constexpr int C_U = 0, C_RQ = 1024, C_RK = 1792, C_RV = 2560, C_RG = 4096, C_DQ = 5632, C_DK = 7168, C_DV = 8704, C_G = 10240;
constexpr float EPS = 1e-6f, LOG2E = 1.4426950408889634f;
constexpr size_t MiB = 1u << 20;
constexpr size_t WS_CTL = 0, CTL_ZERO_BYTES = 1 * MiB;
constexpr int CW_BAR = 4096;
constexpr int CW_SSMF = 12288 + 2048;
constexpr int CW_RSF = 12288;
constexpr int CW_CVQ = 20480, CW_CVD = 20544;
constexpr int CW_ATTQ = 16384;
constexpr size_t SZ_WFI = (size_t)2 * FF * D * 2, SZ_WFO = (size_t)D * FF * 2, SZ_WMIX = (size_t)NIN * D * 2, SZ_WGLU = (size_t)1024 * 1024 * 2, SZ_WBR = (size_t)D * D * 2, SZ_WOUT = (size_t)D * D * 2;
constexpr size_t LW_FI0 = 0, LW_FO0 = LW_FI0 + SZ_WFI, LW_MIX = LW_FO0 + SZ_WFO, LW_GLU = LW_MIX + SZ_WMIX, LW_BR = LW_GLU + SZ_WGLU, LW_OUT = LW_BR + SZ_WBR, LW_FI1 = LW_OUT + SZ_WOUT, LW_FO1 = LW_FI1 + SZ_WFI, LW_SIZE = LW_FO1 + SZ_WFO;
constexpr size_t WS_W = 2 * MiB;
constexpr size_t WS_XN = WS_W + NLAYER * LW_SIZE;
constexpr size_t WS_HID = WS_XN + (size_t)M * D * 2;
constexpr size_t WS_MIXO = WS_HID + (size_t)M * FF * 2;
constexpr size_t WS_YPRE = WS_MIXO + (size_t)M * NIN * 2;
constexpr size_t WS_YCAT = WS_YPRE + (size_t)M * 1024 * 2;
constexpr size_t WS_MERGED = WS_YCAT + (size_t)M * D * 2;
constexpr size_t WS_PREVT = WS_MERGED + (size_t)M * D * 2;
constexpr size_t WS_SSQP = WS_PREVT + (size_t)NB * 6 * 32 * 256 * 128 * 2;
constexpr size_t WS_END = WS_SSQP + (size_t)6 * M * 64 * 4;
static_assert(LW_SIZE % 256 == 0 && WS_XN % 256 == 0 && WS_HID % 256 == 0 && WS_MIXO % 256 == 0 && WS_YPRE % 256 == 0, "alignment");
constexpr int RING_BYTES = 131072, LDSCTL_OFF = RING_BYTES, MISC_OFF = LDSCTL_OFF + 320, QKX_OFF = LDSCTL_OFF + 9216, LDS_BYTES = 148480;

struct Args { const float* in[26]; float* out; unsigned char* ws; int ph_lo, ph_hi; };
enum { I_X = 0, I_NORMW, I_FFNIN, I_FFNOUT, I_MIXIN, I_LRE, I_LIM, I_LOGDT, I_BRE, I_BIM, I_CRE, I_CIM, I_SSMD, I_GLUW, I_GLUB, I_QG, I_KG, I_LQ1, I_LK1, I_LQ2, I_LK2, I_SUBG, I_WBS, I_WBR, I_WBD, I_WOUT };

__device__ __forceinline__ float wave_sum(float v) {
#pragma unroll
    for (int o = 1; o < 64; o <<= 1) v += __shfl_xor(v, o);
    return v;
}
typedef __attribute__((address_space(3))) unsigned char lds_u8;

__device__ __forceinline__ void transpose_item(const float* W, int N, bf16* WT, int ldk, int kofs, int mode, const float* kscale, LAS float* scr, int item, int lane) {
    const int nblk = N / 32, kb = item / nblk, nb = item % nblk, k0 = 64 * kb, n0 = 32 * nb;
    int r0 = n0;
    if (mode == 1) { const int half = n0 >= FF ? 1 : 0, j = n0 - half * FF; r0 = (j >> 7) * 256 + half * 128 + (j & 127); }
    float wv[32];
#pragma unroll
    for (int i = 0; i < 32; ++i) wv[i] = __builtin_nontemporal_load(W + (size_t)(k0 + 2 * i + (lane >> 5)) * N + n0 + (lane & 31));
#pragma unroll
    for (int i = 0; i < 32; ++i) scr[(2 * i + (lane >> 5)) * 33 + (lane & 31)] = wv[i];
    LDS_WAIT(); asm volatile("" ::: "memory");
    const int c = lane & 7;
    f32x4 g0 = {1.f, 1.f, 1.f, 1.f}, g1 = g0;
    if (kscale) { g0 = *(const f32x4*)(kscale + k0 + 8 * c); g1 = *(const f32x4*)(kscale + k0 + 8 * c + 4); }
#pragma unroll
    for (int j = 0; j < 4; ++j) { const int n = (lane >> 3) + 8 * j; const LAS float* s = scr + (8 * c) * 33 + n;
        v4u o; o.x = pk2(s[0 * 33] * g0[0], s[1 * 33] * g0[1]); o.y = pk2(s[2 * 33] * g0[2], s[3 * 33] * g0[3]); o.z = pk2(s[4 * 33] * g1[0], s[5 * 33] * g1[1]); o.w = pk2(s[6 * 33] * g1[2], s[7 * 33] * g1[3]);
        const int slot = r0 + 16 * ((n >> 2) & 1) + 4 * (n >> 3) + (n & 3), kc = kofs + k0 + 8 * c;
        *(GAS v4u*)((GAS unsigned char*)WT + pg8::sub_off((size_t)slot, kc, ldk)) = o; }
    LDS_WAIT(); asm volatile("" ::: "memory");
}
__device__ __forceinline__ void conv_matrix(const float* W, int K, int N, bf16* WT, int ldk, int kofs, int mode, const float* kscale, LAS float* scr, int gw, int NGW, int lane, int part = 0) {
    const int nitems = (K / 64) * (N / 32), cut = nitems / 4;
    const int i0 = part == 2 ? cut : 0, i1 = part == 1 ? cut : nitems;
    for (int it = i0 + gw; it < i1; it += NGW) transpose_item(W, N, WT, ldk, kofs, mode, kscale, scr, it, lane);
}
__device__ __forceinline__ void conv_phase(const Args& a, lds_u8* lds, int sel, int l0, int gw, int NGW, int lane, int wave) {
    LAS float* scr = (LAS float*)(lds + wave * 16384);
    for (int l = (sel == 0 ? 0 : l0); l < (sel == 0 ? NLAYER : l0 + 1); ++l) {
        unsigned char* wl = a.ws + WS_W + (size_t)l * LW_SIZE;
        const bool last = (l + 1 == NLAYER);
        if (sel == 0 && l == 0) conv_matrix(a.in[I_FFNIN] + (size_t)(l * 2 + 0) * D * 2 * FF, D, 2 * FF, (bf16*)(wl + LW_FI0), D, 0, 1, a.in[I_NORMW] + (size_t)(l * 3 + 0) * D, scr, gw, NGW, lane);
        if (sel == 0 && l == 0) conv_matrix(a.in[I_FFNOUT] + (size_t)(l * 2 + 0) * FF * D, FF, D, (bf16*)(wl + LW_FO0), FF, 0, 0, nullptr, scr, gw, NGW, lane);
        if (sel == 1) conv_matrix(a.in[I_MIXIN] + (size_t)l * D * NIN, D, NIN, (bf16*)(wl + LW_MIX), D, 0, 0, a.in[I_NORMW] + (size_t)(l * 3 + 1) * D, scr, gw, NGW, lane);
        if (sel == 2 && !last) {
            unsigned char* wn = wl + LW_SIZE;
            conv_matrix(a.in[I_FFNIN] + (size_t)((l + 1) * 2 + 0) * D * 2 * FF, D, 2 * FF, (bf16*)(wn + LW_FI0), D, 0, 1, a.in[I_NORMW] + (size_t)((l + 1) * 3 + 0) * D, scr, gw, NGW, lane); }
        if (sel == 2 && last) conv_matrix(a.in[I_FFNOUT] + (size_t)(l * 2 + 1) * FF * D, FF, D, (bf16*)(wl + LW_FO1), FF, 0, 0, nullptr, scr, gw, NGW, lane);
    }
}
constexpr int CVN_GLU = 16 * 32, CVN_BS = 16 * (D / 32), CVN_BR = 24 * (D / 32), CVN_OUT = (D / 64) * (D / 32), CVN_FI = (D / 64) * (2 * FF / 32), CVN_FO = (FF / 64) * (D / 32);
constexpr int CVN_MID = CVN_GLU + CVN_BS + 2 * CVN_BR + CVN_OUT + CVN_FI;
constexpr int CV_TOTAL = NLAYER * CVN_MID + (NLAYER - 1) * 2 * CVN_FO;
__host__ __device__ constexpr int cv_deadline(int l, int k) {
    int base = l * CVN_MID + (l > 0 ? (2 * l - 1) * CVN_FO : 0);
    if (l > 0) { if (k < 0) return base; base += CVN_FO; }
    int v = base;
    if (k >= 2) v = base + CVN_GLU;
    if (k >= 4) v = base + CVN_GLU + CVN_BS + 2 * CVN_BR;
    if (k >= 5) v = base + CVN_GLU + CVN_BS + 2 * CVN_BR + CVN_OUT;
    if (k >= 6) v = base + CVN_MID;
    if (k >= 7 && l + 1 < NLAYER) v = base + CVN_MID + CVN_FO;
    return v;
}
__device__ __forceinline__ void conv_stream_item(const Args& a, int it, LAS float* scr, int lane) {
    const float* W = nullptr; int N = 0; bf16* WT = nullptr; int ldk = 0, kofs = 0, mode = 0; const float* ks = nullptr; bool found = false;
#define CV_SEG(n_, W_, N_, WT_, ldk_, kofs_, mode_, ks_) if (!found) { if (it < (n_)) { W = (W_); N = (N_); WT = (bf16*)(WT_); ldk = (ldk_); kofs = (kofs_); mode = (mode_); ks = (ks_); found = true; } else it -= (n_); }
    for (int l = 0; l < NLAYER; ++l) { unsigned char* wl = a.ws + WS_W + (size_t)l * LW_SIZE;
        if (l > 0) CV_SEG(CVN_FO, a.in[I_FFNOUT] + (size_t)(l * 2 + 0) * FF * D, D, wl + LW_FO0, FF, 0, 0, nullptr)
        CV_SEG(CVN_GLU, a.in[I_GLUW] + (size_t)l * 1024 * 1024, 1024, wl + LW_GLU, 1024, 0, 0, nullptr)
        CV_SEG(CVN_BS, a.in[I_WBS] + (size_t)l * 1024 * D, D, wl + LW_BR, D, 0, 0, nullptr)
        CV_SEG(CVN_BR, a.in[I_WBR] + (size_t)l * 1536 * D, D, wl + LW_BR, D, 1024, 0, nullptr)
        CV_SEG(CVN_BR, a.in[I_WBD] + (size_t)l * 1536 * D, D, wl + LW_BR, D, 2560, 0, nullptr)
        CV_SEG(CVN_OUT, a.in[I_WOUT] + (size_t)l * D * D, D, wl + LW_OUT, D, 0, 0, nullptr)
        CV_SEG(CVN_FI, a.in[I_FFNIN] + (size_t)(l * 2 + 1) * D * 2 * FF, 2 * FF, wl + LW_FI1, D, 0, 1, a.in[I_NORMW] + (size_t)(l * 3 + 2) * D)
        if (l + 1 < NLAYER) CV_SEG(CVN_FO, a.in[I_FFNOUT] + (size_t)(l * 2 + 1) * FF * D, D, wl + LW_FO1, FF, 0, 0, nullptr)
    }
#undef CV_SEG
    if (found) transpose_item(W, N, WT, ldk, kofs, mode, ks, scr, it, lane);
}
__device__ __forceinline__ void conv_drain(const Args& a, lds_u8* lds, int seam, int mand_items, int tid, int lane, int wave) {
    constexpr unsigned NB8 = (unsigned)((CV_TOTAL + 7) / 8);
    unsigned* ctl = (unsigned*)(a.ws + WS_CTL); unsigned* tq = ctl + CW_CVQ; unsigned* dn = ctl + CW_CVD + 64 * seam;
    volatile LAS unsigned* tk = (volatile LAS unsigned*)(lds + MISC_OFF) + 13;
    const unsigned mandb = (unsigned)((mand_items + 7) / 8), G = gridDim.x;
    LAS float* scr = (LAS float*)(lds + wave * 16384);
    __syncthreads();
    if (tid == 0) (void)__hip_atomic_fetch_add(dn, 1u, __ATOMIC_RELAXED, __HIP_MEMORY_SCOPE_AGENT);
    for (;;) {
        if (tid == 0) { const unsigned d = xb_ld(dn), c = xb_ld(tq); unsigned t = 0xffffffffu;
            if (c < NB8 && (c < mandb || d < G)) t = __hip_atomic_fetch_add(tq, 1u, __ATOMIC_RELAXED, __HIP_MEMORY_SCOPE_AGENT);
            *tk = t; }
        __syncthreads();
        const unsigned t = (unsigned)__builtin_amdgcn_readfirstlane((int)*tk);
        if (t >= NB8) break;
        const int it = (int)t * 8 + wave;
        if (it < CV_TOTAL) conv_stream_item(a, it, scr, lane);
        __syncthreads();
    }
}
__device__ __forceinline__ void cast_phase(const float* x, bf16* h16, float* ssq, int gw, int NGW, int lane) {
    for (int m = gw; m < M; m += NGW) {
        const GAS f32x4* xr = (const GAS f32x4*)(x + (size_t)m * D) + lane;
        float s = 0.f;
#pragma unroll
        for (int j = 0; j < 16; ++j) { const f32x4 v = xr[64 * j]; s += (v.x * v.x + v.y * v.y) + (v.z * v.z + v.w * v.w); v2u w; w.x = pk2(v.x, v.y); w.y = pk2(v.z, v.w);
            *(GAS v2u*)((GAS unsigned char*)h16 + pg8::sub_off((size_t)m, 4 * lane + 256 * j, D)) = w; }
        s = wave_sum(s);
        ssq[(size_t)m * 64 + lane] = lane == 0 ? s : 0.f;
    }
}
__device__ __forceinline__ float gelu_tanh(float x) { const float z = 0.7978845608028654f * (x + 0.044715f * x * x * x); return x * sigm(2.0f * z); }
#define MFMA16(A, B, C) __builtin_amdgcn_mfma_f32_16x16x32_bf16((A), (B), (C), 0, 0, 0)
__device__ __forceinline__ void ssm_phase(const Args& a, int layer, lds_u8* lds, int lane, int wave, int first, int stride) {
    const bf16* mixo = (const bf16*)(a.ws + WS_MIXO); bf16* ypre = (bf16*)(a.ws + WS_YPRE);
    lds_u8* wb = lds + wave * 13312;
    LAS float* BU = (LAS float*)wb;
    lds_u8* Xs = wb + 8192;
    lds_u8* Ub = wb + 12288;
    lds_u8* Yb = wb + 12800;
    LAS float* sS = (LAS float*)(lds + 106496);
    lds_u8* Bt = lds + 110592;
    lds_u8* Ct = lds + 114688;
    const int l15 = lane & 15, kq = lane >> 4;
    for (int item = first; item < NB * 64; item += stride) {
        const int b = item >> 6, g = item & 63, lg = layer * 64 + g, p = lane;
        const float dt = expf(a.in[I_LOGDT][lg]);
        const float lr = a.in[I_LRE][lg * 64 + p], li = a.in[I_LIM][lg * 64 + p];
        const float mag = expf(lr * dt); float sn, cs; sincosf(li * dt, &sn, &cs);
        const float ar = mag * cs, ai = mag * sn;
        __syncthreads();
        if (wave == 0) {
            const float den = lr * lr + li * li, nr = ar - 1.0f, ni = ai;
            const float cfr = (nr * lr + ni * li) / den, cfi = (ni * lr - nr * li) / den;
            const float* br = a.in[I_BRE] + ((size_t)lg * 64 + p) * 16; const float* bi = a.in[I_BIM] + ((size_t)lg * 64 + p) * 16;
            unsigned wre[8], wim[8];
#pragma unroll
            for (int i = 0; i < 8; ++i) { const float r0 = cfr * br[2 * i] - cfi * bi[2 * i], r1 = cfr * br[2 * i + 1] - cfi * bi[2 * i + 1], i0 = cfr * bi[2 * i] + cfi * br[2 * i], i1 = cfr * bi[2 * i + 1] + cfi * br[2 * i + 1];
                wre[i] = pk2(r0, r1); wim[i] = pk2(i0, i1); }
            *(LAS v4u*)(Bt + (2 * p) * 32) = (v4u){wre[0], wre[1], wre[2], wre[3]}; *(LAS v4u*)(Bt + (2 * p) * 32 + 16) = (v4u){wre[4], wre[5], wre[6], wre[7]};
            *(LAS v4u*)(Bt + (2 * p + 1) * 32) = (v4u){wim[0], wim[1], wim[2], wim[3]}; *(LAS v4u*)(Bt + (2 * p + 1) * 32 + 16) = (v4u){wim[4], wim[5], wim[6], wim[7]};
#pragma unroll
            for (int i = 0; i < 16; ++i) { const float cr_ = a.in[I_CRE][((size_t)lg * 16 + i) * 64 + p], ci_ = a.in[I_CIM][((size_t)lg * 16 + i) * 64 + p];
                *(LAS unsigned*)(Ct + i * 256 + p * 4) = pk2(cr_, -ci_); }
        }
        float pr = ar, pi = ai;
#pragma unroll
        for (int k = 0; k < 9; ++k) { const float n1 = pr * pr - pi * pi, n2 = 2.0f * pr * pi; pr = n1; pi = n2; }
        __syncthreads();
        bf16x8 bfrag[8], cfrag[4];
#pragma unroll
        for (int nb = 0; nb < 8; ++nb) { bfrag[nb] = (bf16x8){0, 0, 0, 0, 0, 0, 0, 0}; if (kq < 2) bfrag[nb] = *(const LAS bf16x8*)(Bt + (16 * nb + l15) * 32 + kq * 16); }
#pragma unroll
        for (int ks = 0; ks < 4; ++ks) cfrag[ks] = *(const LAS bf16x8*)(Ct + l15 * 256 + (32 * ks + 8 * kq) * 2);
        const float dsk = a.in[I_SSMD][lg * 16 + l15];
        const size_t rowbase = (size_t)b * SEQ + wave * 512;
        const bf16* up = mixo + (rowbase + l15) * NIN + C_U + g * 16 + (kq & 1) * 8;
        float xr = 0.f, xi = 0.f;
        for (int pass = 0; pass < 2; ++pass) {
            bf16x8 ufr = *(const bf16x8*)up;
            for (int ch = 0; ch < 32; ++ch) {
                bf16x8 ua = ufr; if (kq >= 2) ua = (bf16x8){0, 0, 0, 0, 0, 0, 0, 0};
                if (ch + 1 < 32) ufr = *(const bf16x8*)(up + (size_t)(ch + 1) * 16 * NIN);
                if (pass == 1 && kq < 2) *(LAS bf16x8*)(Ub + l15 * 32 + kq * 16) = ua;
#pragma unroll
                for (int nb = 0; nb < 8; ++nb) { f32x4 acc = {0.f, 0.f, 0.f, 0.f}; acc = MFMA16(ua, bfrag[nb], acc);
#pragma unroll
                    for (int r = 0; r < 4; ++r) BU[(4 * kq + r) * 128 + 16 * nb + l15] = acc[r]; }
#pragma unroll
                for (int t = 0; t < 16; ++t) { const f32x2v bu = *(const LAS f32x2v*)(BU + t * 128 + 2 * p);
                    const float n1 = ar * xr - ai * xi + bu.x, n2 = ar * xi + ai * xr + bu.y; xr = n1; xi = n2;
                    if (pass == 1) *(LAS unsigned*)(Xs + t * 256 + p * 4) = pk2(xr, xi); }
                if (pass == 1) {
                    f32x4 y = {0.f, 0.f, 0.f, 0.f};
#pragma unroll
                    for (int ks = 0; ks < 4; ++ks) { const bf16x8 xa = *(const LAS bf16x8*)(Xs + l15 * 256 + (32 * ks + 8 * kq) * 2); y = MFMA16(xa, cfrag[ks], y); }
#pragma unroll
                    for (int r = 0; r < 4; ++r) { const int t = 4 * kq + r; const float u = __uint_as_float((unsigned)(*(const LAS unsigned short*)(Ub + t * 32 + l15 * 2)) << 16);
                        *(LAS unsigned short*)(Yb + t * 32 + l15 * 2) = (unsigned short)(pk2(gelu_tanh(y[r] + dsk * u), 0.f) & 0xffffu); }
                    if (lane < 32) *(v4u*)((unsigned char*)ypre + pg8::sub_off(rowbase + ch * 16 + (lane >> 1), g * 16 + (lane & 1) * 8, 1024)) = *(const LAS v4u*)(Yb + (lane >> 1) * 32 + (lane & 1) * 16);
                }
            }
            if (pass == 0) {
                sS[(wave * 64 + lane) * 2] = xr; sS[(wave * 64 + lane) * 2 + 1] = xi;
                __syncthreads();
                float ir = 0.f, ii = 0.f;
                for (int v = 0; v < wave; ++v) { const float sr = sS[(v * 64 + lane) * 2], si = sS[(v * 64 + lane) * 2 + 1]; const float n1 = pr * ir - pi * ii + sr, n2 = pr * ii + pi * ir + si; ir = n1; ii = n2; }
                xr = ir; xi = ii;
            }
        }
    }
}
__device__ __forceinline__ void qknorm_phase(const Args& a, int layer, int gw, int NGW, int lane) {
    bf16* mixo = (bf16*)(a.ws + WS_MIXO);
    float gq[8], gk[8];
#pragma unroll
    for (int j = 0; j < 8; ++j) { gq[j] = a.in[I_QG][layer * 64 + (lane & 7) * 8 + j] * (0.125f * LOG2E); gk[j] = a.in[I_KG][layer * 64 + (lane & 7) * 8 + j]; }
    for (int m = gw; m < M; m += NGW) {
#pragma unroll
        for (int part = 0; part < 2; ++part)
#pragma unroll
            for (int it = 0; it < 3; ++it) {
                bf16* p = mixo + (size_t)m * NIN + (part ? C_DK : C_DQ) + it * 512 + lane * 8;
                const v4u w = *(const v4u*)p;
                float f[8] = {bflo(w.x), bfhi(w.x), bflo(w.y), bfhi(w.y), bflo(w.z), bfhi(w.z), bflo(w.w), bfhi(w.w)};
                float ss = 0.f;
#pragma unroll
                for (int j = 0; j < 8; ++j) ss += f[j] * f[j];
                ss += __shfl_xor(ss, 1); ss += __shfl_xor(ss, 2); ss += __shfl_xor(ss, 4);
                const float r = 1.0f / sqrtf(ss * (1.0f / 64.0f) + EPS);
#pragma unroll
                for (int j = 0; j < 8; ++j) f[j] *= r * (part ? gk[j] : gq[j]);
                *(v4u*)p = (v4u){pk2(f[0], f[1]), pk2(f[2], f[3]), pk2(f[4], f[5]), pk2(f[6], f[7])};
            }
    }
}
__device__ __forceinline__ int tr_lane_off(int lane, int rs) { const int i = lane & 15; return (4 * (lane >> 5) + (i >> 2)) * rs + (16 * ((lane >> 4) & 1) + 4 * (i & 3)) * 2; }
__device__ __forceinline__ bf16x8 tr_frag(const lds_u8* p, int rs8) {
    const v4i16_t lo = __builtin_amdgcn_ds_read_tr16_b64_v4i16((LAS v4i16_t*)p), hi = __builtin_amdgcn_ds_read_tr16_b64_v4i16((LAS v4i16_t*)(p + rs8));
    return (bf16x8){lo[0], lo[1], lo[2], lo[3], hi[0], hi[1], hi[2], hi[3]};
}
__device__ __forceinline__ bf16x8 pack8(float a0, float a1, float a2, float a3, float a4, float a5, float a6, float a7) {
    const v4u w = {pk2(a0, a1), pk2(a2, a3), pk2(a4, a5), pk2(a6, a7)}; return __builtin_bit_cast(bf16x8, w);
}
#define MFMA32(A, B, C) __builtin_amdgcn_mfma_f32_32x32x16_bf16((A), (B), (C), 0, 0, 0)
__device__ __forceinline__ f32x16 zero16() { f32x16 z; for (int i = 0; i < 16; ++i) z[i] = 0.f; return z; }

__device__ __forceinline__ void ret_state_phase(const Args& a, int layer, lds_u8* lds, int tid, int lane, int wave) {
    constexpr int RS = 320;
    const bf16* mixo = (const bf16*)(a.ws + WS_MIXO); bf16* prevT = (bf16*)(a.ws + WS_PREVT);
    lds_u8* Ks = lds; lds_u8* Vs = lds + 128 * RS; lds_u8* Ss = lds + 2 * 128 * RS;
    const int troff = tr_lane_off(lane, RS), l31 = lane & 31, hh = lane >> 5;
    const int dvb = wave >> 1, dkb0 = (wave & 1) * 2;
    for (int item = (int)gridDim.x - 1 - (int)blockIdx.x; item < NB * 6 * 2; item += gridDim.x) {
        const int dvh = item & 1, h = (item >> 1) % 6, b = item / 12;
        const float lg2 = log2f(1.0f - exp2f(-5.0f - (float)h)), cd = ex2(lg2 * 128.0f);
        f32x16 st0 = zero16(), st1 = zero16();
        v4u kreg0[4], vreg0[4], kreg1[4], vreg1[4];
#define RS_LOAD(KR, VR, n) do { _Pragma("unroll") for (int i_ = 0; i_ < 4; ++i_) { const int cid_ = tid + 512 * i_, row_ = cid_ >> 4, cc_ = cid_ & 15; const bf16* rp_ = mixo + ((size_t)b * SEQ + (n) * 128 + row_) * NIN; \
            KR[i_] = *(const v4u*)(rp_ + C_RK + h * 128 + cc_ * 8); VR[i_] = *(const v4u*)(rp_ + C_RV + h * 256 + dvh * 128 + cc_ * 8); } } while (0)
#define RS_PART_A(n) { \
            _Pragma("unroll") for (int rq = 0; rq < 4; ++rq) { \
                *(LAS v2u*)(Ss + (dvb * 32 + l31) * 272 + (dkb0 * 32 + 8 * rq + 4 * hh) * 2) = (v2u){pk2(st0[4 * rq], st0[4 * rq + 1]), pk2(st0[4 * rq + 2], st0[4 * rq + 3])}; \
                *(LAS v2u*)(Ss + (dvb * 32 + l31) * 272 + ((dkb0 + 1) * 32 + 8 * rq + 4 * hh) * 2) = (v2u){pk2(st1[4 * rq], st1[4 * rq + 1]), pk2(st1[4 * rq + 2], st1[4 * rq + 3])}; } \
            __syncthreads();                                     \
            { bf16* pt = prevT + ((size_t)((b * 6 + h) * 32 + (n)) * 256 + dvh * 128) * 128; \
              v4u sv_[4]; _Pragma("unroll") for (int i = 0; i < 4; ++i) { const int cid = tid + 512 * i, row = cid >> 4, cc = cid & 15; sv_[i] = *(const LAS v4u*)(Ss + row * 272 + cc * 16); } \
              _Pragma("unroll") for (int i = 0; i < 4; ++i) { const int cid = tid + 512 * i, row = cid >> 4, cc = cid & 15; *(v4u*)(pt + row * 128 + cc * 8) = sv_[i]; } } }
#define RS_PART_B(KR, VR, n) { \
            _Pragma("unroll") for (int i = 0; i < 4; ++i) { const int cid = tid + 512 * i, row = cid >> 4, cc = cid & 15; const float sc = ex2(lg2 * (float)(127 - row)) * 0.08838834764831845f; \
                const v4u k = KR[i]; \
                const v4u ks = {pk2(bflo(k.x) * sc, bfhi(k.x) * sc), pk2(bflo(k.y) * sc, bfhi(k.y) * sc), pk2(bflo(k.z) * sc, bfhi(k.z) * sc), pk2(bflo(k.w) * sc, bfhi(k.w) * sc)}; \
                *(LAS v4u*)(Ks + row * RS + cc * 16) = ks; *(LAS v4u*)(Vs + row * RS + cc * 16) = VR[i]; } \
            __syncthreads(); \
            if ((n) + 2 < 31) RS_LOAD(KR, VR, (n) + 2); \
            st0 *= cd; st1 *= cd; \
            { bf16x8 A = tr_frag(Vs + troff + dvb * 64, 8 * RS), B0 = tr_frag(Ks + troff + dkb0 * 64, 8 * RS), B1 = tr_frag(Ks + troff + (dkb0 + 1) * 64, 8 * RS); \
              _Pragma("unroll") for (int s = 0; s < 8; ++s) { \
                  bf16x8 An = A, B0n = B0, B1n = B1; \
                  if (s + 1 < 8) { An = tr_frag(Vs + troff + 16 * (s + 1) * RS + dvb * 64, 8 * RS); B0n = tr_frag(Ks + troff + 16 * (s + 1) * RS + dkb0 * 64, 8 * RS); B1n = tr_frag(Ks + troff + 16 * (s + 1) * RS + (dkb0 + 1) * 64, 8 * RS); } \
                  st0 = MFMA32(B0, A, st0); st1 = MFMA32(B1, A, st1); \
                  A = An; B0 = B0n; B1 = B1n; \
              } } }
        RS_LOAD(kreg0, vreg0, 0); RS_LOAD(kreg1, vreg1, 1);
        for (int n = 0; n < 32; n += 2) {
            RS_PART_A(n); RS_PART_B(kreg0, vreg0, n);
            RS_PART_A(n + 1); if (n == 30) break;
            RS_PART_B(kreg1, vreg1, n + 1);
        }
#undef RS_PART_A
#undef RS_PART_B
#undef RS_LOAD
        asm volatile("s_waitcnt vmcnt(0)" ::: "memory");
        __syncthreads();
        if (tid == 0) { __builtin_amdgcn_fence(__ATOMIC_RELEASE, "agent"); asm volatile("s_waitcnt vmcnt(0)" ::: "memory");
            (void)__hip_atomic_fetch_add((unsigned*)(a.ws + WS_CTL) + CW_RSF + 64 * layer, 1u, __ATOMIC_RELAXED, __HIP_MEMORY_SCOPE_AGENT); }
    }
}
__device__ __forceinline__ void ret_state_wait(const Args& a, int layer, int tid) {
    if (tid == 0) { unsigned* ctl = (unsigned*)(a.ws + WS_CTL); unsigned* bar = ctl + CW_BAR;
        XB_SPIN(xb_ld(ctl + CW_RSF + 64 * layer) < (unsigned)(NB * 6 * 2), bar);
        __builtin_amdgcn_fence(__ATOMIC_ACQUIRE, "agent"); asm volatile("s_waitcnt vmcnt(0)" ::: "memory"); }
    __syncthreads();
}
__device__ __forceinline__ void ret_out_phase(const Args& a, lds_u8* lds, int tid, int lane, int wave) {
    constexpr int RK = 272, RV = 576, RO = 528;
    const bf16* mixo = (const bf16*)(a.ws + WS_MIXO); const bf16* prevT = (const bf16*)(a.ws + WS_PREVT); bf16* ycat = (bf16*)(a.ws + WS_YCAT);
    lds_u8* Ks = lds; lds_u8* Vs = lds + 128 * RK; lds_u8* Ps = lds; lds_u8* Os = lds;
    LAS float* ssS = (LAS float*)(lds + 112640);
    const int qb = wave & 3, dvh = wave >> 2, l31 = lane & 31, hh = lane >> 5;
    const int troffV = tr_lane_off(lane, RV);
    for (int item = blockIdx.x; item < NB * 32 * 6; item += gridDim.x) {
        const int h = item % 6, n = (item / 6) & 31, b = item / 192;
        const float lg2 = log2f(1.0f - exp2f(-5.0f - (float)h));
        const size_t row0 = (size_t)b * SEQ + n * 128;
        __syncthreads();
#pragma unroll
        for (int i = 0; i < 4; ++i) { const int cid = tid + 512 * i, row = cid >> 4, cc = cid & 15; const float sc = ex2(-lg2 * (float)(row + 1)) * 0.08838834764831845f;
            const v4u k = *(const v4u*)(mixo + (row0 + row) * NIN + C_RK + h * 128 + cc * 8);
            const v4u ks = {pk2(bflo(k.x) * sc, bfhi(k.x) * sc), pk2(bflo(k.y) * sc, bfhi(k.y) * sc), pk2(bflo(k.z) * sc, bfhi(k.z) * sc), pk2(bflo(k.w) * sc, bfhi(k.w) * sc)};
            *(LAS v4u*)(Ks + row * RK + cc * 16) = ks; }
#pragma unroll 4
        for (int i = 0; i < 8; ++i) { const int cid = tid + 512 * i, row = cid >> 5, cc = cid & 31; *(LAS v4u*)(Vs + row * RV + cc * 16) = *(const v4u*)(mixo + (row0 + row) * NIN + C_RV + h * 256 + cc * 8); }
        bf16x8 qf[8];
        { const bf16* qp = mixo + (row0 + qb * 32 + l31) * NIN + C_RQ + h * 128 + 8 * hh;
#pragma unroll
          for (int s = 0; s < 8; ++s) qf[s] = *(const bf16x8*)(qp + 16 * s); }
        v4u pv[8];
        { const bf16* pt = prevT + (size_t)((b * 6 + h) * 32 + n) * 256 * 128;
#pragma unroll
          for (int i = 0; i < 8; ++i) { const int cid = tid + 512 * i, row = cid >> 4, cc = cid & 15; pv[i] = *(const v4u*)(pt + row * 128 + cc * 8); } }
        f32x16 o[4];
#pragma unroll
        for (int db = 0; db < 4; ++db) o[db] = zero16();
        __syncthreads();
#pragma unroll
        for (int kb = 0; kb < 4; ++kb) {
            if (kb <= qb) {
                f32x16 st = zero16();
#pragma unroll
                for (int s = 0; s < 8; ++s) { const bf16x8 A = *(const LAS bf16x8*)(Ks + (kb * 32 + l31) * RK + (16 * s + 8 * hh) * 2); st = MFMA32(A, qf[s], st); }
                if (kb == qb) {
#pragma unroll
                    for (int r = 0; r < 16; ++r) if ((r & 3) + 8 * (r >> 2) + 4 * hh > l31) st[r] = 0.f;
                }
                const bf16x8 p0 = pack8(st[0], st[1], st[2], st[3], st[4], st[5], st[6], st[7]), p1 = pack8(st[8], st[9], st[10], st[11], st[12], st[13], st[14], st[15]);
#pragma unroll
                for (int db = 0; db < 4; ++db) { const bf16x8 A0 = tr_frag(Vs + troffV + 32 * kb * RV + (dvh * 128 + db * 32) * 2, 8 * RV), A1 = tr_frag(Vs + troffV + (32 * kb + 16) * RV + (dvh * 128 + db * 32) * 2, 8 * RV);
                    o[db] = MFMA32(A0, p0, o[db]); o[db] = MFMA32(A1, p1, o[db]); }
            }
            __builtin_amdgcn_sched_barrier(0);
        }
        __syncthreads();
#pragma unroll
        for (int i = 0; i < 8; ++i) { const int cid = tid + 512 * i, row = cid >> 4, cc = cid & 15; *(LAS v4u*)(Ps + row * RK + cc * 16) = pv[i]; }
        v4u gv[8];
#pragma unroll
        for (int i = 0; i < 8; ++i) { const int cid = tid + 512 * i, row = cid >> 5, cc = cid & 31; gv[i] = *(const v4u*)(mixo + (row0 + row) * NIN + C_RG + h * 256 + cc * 8); }
        __syncthreads();
#pragma unroll
        for (int db = 0; db < 4; ++db) {
#pragma unroll
            for (int s = 0; s < 8; ++s) { const bf16x8 A = *(const LAS bf16x8*)(Ps + (dvh * 128 + db * 32 + l31) * RK + (16 * s + 8 * hh) * 2); o[db] = MFMA32(A, qf[s], o[db]); }
            __builtin_amdgcn_sched_barrier(0);
        }
        float ss = 0.f;
#pragma unroll
        for (int db = 0; db < 4; ++db)
#pragma unroll
            for (int r = 0; r < 16; ++r) ss += o[db][r] * o[db][r];
        ss += __shfl_xor(ss, 32);
        if (hh == 0) ssS[wave * 32 + l31] = ss;
        __syncthreads();
        const float rstd = 1.0f / sqrtf((ssS[wave * 32 + l31] + ssS[(wave ^ 4) * 32 + l31]) * (1.0f / 256.0f) + EPS * ex2(-2.0f * lg2 * (float)(qb * 32 + l31 + 1)));
#pragma unroll
        for (int db = 0; db < 4; ++db)
#pragma unroll
            for (int rq = 0; rq < 4; ++rq) { const int dv = dvh * 128 + db * 32 + 8 * rq + 4 * hh;
                const v2u w = {pk2(o[db][4 * rq] * rstd, o[db][4 * rq + 1] * rstd), pk2(o[db][4 * rq + 2] * rstd, o[db][4 * rq + 3] * rstd)};
                *(LAS v2u*)(Os + (qb * 32 + l31) * RO + dv * 2) = w; }
        __syncthreads();
#pragma unroll
        for (int i = 0; i < 8; ++i) { const int cid = tid + 512 * i, row = cid >> 5, cc = cid & 31;
            const v4u ov = *(const LAS v4u*)(Os + row * RO + cc * 16);
            float g[8] = {bflo(gv[i].x), bfhi(gv[i].x), bflo(gv[i].y), bfhi(gv[i].y), bflo(gv[i].z), bfhi(gv[i].z), bflo(gv[i].w), bfhi(gv[i].w)};
            float ov8[8] = {bflo(ov.x), bfhi(ov.x), bflo(ov.y), bfhi(ov.y), bflo(ov.z), bfhi(ov.z), bflo(ov.w), bfhi(ov.w)};
#pragma unroll
            for (int j = 0; j < 8; ++j) ov8[j] *= g[j] * sigm(g[j]);
            *(v4u*)((unsigned char*)ycat + pg8::sub_off(row0 + row, 1024 + h * 256 + cc * 8, D)) = (v4u){pk2(ov8[0], ov8[1]), pk2(ov8[2], ov8[3]), pk2(ov8[4], ov8[5]), pk2(ov8[6], ov8[7])}; }
    }
}
__device__ __forceinline__ void glds16(const void* gsrc, unsigned lds_dst) { unsigned keep;
    asm volatile("s_mov_b32 %0, m0\n\ts_mov_b32 m0, %2\n\ts_nop 0\n\tglobal_load_lds_dwordx4 %1, off\n\ts_mov_b32 m0, %0" : "=&s"(keep) : "v"(gsrc), "s"(lds_dst) : "memory"); }
__device__ __forceinline__ void attn_phase(const Args& a, int layer, lds_u8* lds, int tid, int lane, int wave) {
    constexpr int RK = 144, RV = 320, STG = 2 * 64 * RK + 64 * RV;
    const bf16* mixo = (const bf16*)(a.ws + WS_MIXO); bf16* ycat = (bf16*)(a.ws + WS_YCAT);
    const int l31 = lane & 31, hh = lane >> 5, map = wave >> 2, qs = wave & 3;
    const int troffV = tr_lane_off(lane, RV);
    const float lambda_init = 0.8f - 0.6f * expf(-0.3f * (float)layer);
    float lam;
    { const float s1 = wave_sum(a.in[I_LQ1][layer * 64 + lane] * a.in[I_LK1][layer * 64 + lane]), s2 = wave_sum(a.in[I_LQ2][layer * 64 + lane] * a.in[I_LK2][layer * 64 + lane]);
      lam = expf(s1) - expf(s2) + lambda_init; lam = __uint_as_float(__builtin_amdgcn_readfirstlane(__float_as_uint(lam))); }
    float thr, s2max;
    { float mq = fabsf(a.in[I_QG][layer * 64 + lane]), mk = fabsf(a.in[I_KG][layer * 64 + lane]);
#pragma unroll
      for (int o = 1; o < 64; o <<= 1) { mq = fmaxf(mq, __shfl_xor(mq, o)); mk = fmaxf(mk, __shfl_xor(mk, o)); }
      s2max = (8.0f * LOG2E * mq * mk) * 1.01f; s2max = __uint_as_float(__builtin_amdgcn_readfirstlane(__float_as_uint(s2max))); thr = 152.0f + 2.0f * s2max; }
    const int G = gridDim.x, xch = blockIdx.x & 7;
    const unsigned hpack = (xch & 1) ? 0x1349ABu : 0x025678u;
    unsigned* qctr = (unsigned*)(a.ws + WS_CTL) + CW_ATTQ + (layer * 8 + xch) * 64;
    volatile LAS unsigned* tick = (volatile LAS unsigned*)(lds + MISC_OFF) + 12;
    for (int rnd = 0;; ++rnd) {
        int b, hd, qb;
        if (G == 256) {
            if (tid == 0) *tick = __hip_atomic_fetch_add(qctr, 1u, __ATOMIC_RELAXED, __HIP_MEMORY_SCOPE_AGENT);
            __syncthreads();
            const int u = __builtin_amdgcn_readfirstlane((int)*tick); if (u >= 192) break;
            b = xch >> 1; hd = (hpack >> (4 * (u >> 5))) & 15; qb = 31 - (u & 31); }
        else { const int u = rnd * G + blockIdx.x; if (u >= NB * 12 * 32) break; qb = 31 - u / 48; b = (u % 48) / 12; hd = u % 12; }
        const float slope2 = exp2f(-8.0f * (float)(hd + 1) / 12.0f) * LOG2E;
        const size_t row0 = (size_t)b * SEQ;
        const int qw = qb * 128 + qs * 32;
        bf16x8 qf[4];
        { const bf16* qp = mixo + (row0 + qw + l31) * NIN + C_DQ + hd * 128 + map * 64 + 8 * hh;
#pragma unroll
          for (int s = 0; s < 4; ++s) qf[s] = *(const bf16x8*)(qp + 16 * s); }
        f32x16 o[4];
#pragma unroll
        for (int db = 0; db < 4; ++db) o[db] = zero16();
        float lrun = 0.f;
        const int kt1 = 2 * qb + 1; int kt0; { const int W = (int)fminf(thr / slope2, 100000.0f) + 1, x = 128 * qb - W - 63; kt0 = x <= 0 ? 0 : (x + 63) >> 6; }
        const int ntile = kt1 - kt0 + 1;
        constexpr int STG3 = 40 * 1024;
        unsigned goff[5];
#pragma unroll
        for (int i = 0; i < 5; ++i) { int c = (wave + 8 * i) * 64 + lane; asm volatile("" : "+v"(c)); int row, colb;
            if (c < 576) { row = c / 9; const int cc = c - row * 9; colb = (C_DK + hd * 128) * 2 + (cc > 7 ? 7 : cc) * 16; }
            else if (c < 1152) { const int c2 = c - 576; row = c2 / 9; const int cc = c2 - row * 9; colb = (C_DK + hd * 128 + 64) * 2 + (cc > 7 ? 7 : cc) * 16; }
            else if (c < 2432) { const int c3 = c - 1152; row = c3 / 20; const int cc = c3 - row * 20; colb = (C_DV + hd * 128) * 2 + (cc > 15 ? 15 : cc) * 16; }
            else { row = 0; colb = (C_DK + hd * 128) * 2; }
            goff[i] = (unsigned)row * (unsigned)(NIN * 2) + (unsigned)colb; }
        const char* tile0 = (const char*)(mixo + (row0 + (size_t)kt0 * 64) * NIN);
        const unsigned lds_base = (unsigned)(size_t)lds;
        bf16x8 pf[4];
#define ATT_DMA(it, stg) do { const char* tb_ = tile0 + (size_t)(it) * (64 * NIN * 2); _Pragma("unroll") for (int i_ = 0; i_ < 5; ++i_) \
            glds16(tb_ + goff[i_], lds_base + (unsigned)((stg) * STG3 + (wave + 8 * i_) * 1024)); } while (0)
#define ATT_TILE(it, sbase) do { const int kt_ = kt0 + (it); { const lds_u8* Kb = (sbase) + map * 64 * RK; f32x16 st[2]; \
            const float b0 = slope2 * (float)(kt_ * 64 + 4 * hh - (qw + l31)) - s2max; \
            _Pragma("unroll") for (int kb2 = 0; kb2 < 2; ++kb2) _Pragma("unroll") for (int r = 0; r < 16; ++r) st[kb2][r] = b0 + slope2 * (float)(kb2 * 32 + (r & 3) + 8 * (r >> 2)); \
            bf16x8 kf_[8];   \
            _Pragma("unroll") for (int i_ = 0; i_ < 8; ++i_) kf_[i_] = *(const LAS bf16x8*)(Kb + ((i_ >> 2) * 32 + l31) * RK + (16 * (i_ & 3) + 8 * hh) * 2); \
            _Pragma("unroll") for (int s = 0; s < 4; ++s) { st[0] = MFMA32(kf_[s], qf[s], st[0]); st[1] = MFMA32(kf_[4 + s], qf[s], st[1]); } \
            ATT_H2A(sbase); \
            if (kt_ * 64 + 63 > qw) { const int qrel = qw + l31 - kt_ * 64 - 4 * hh; \
                _Pragma("unroll") for (int kb2 = 0; kb2 < 2; ++kb2) _Pragma("unroll") for (int r = 0; r < 16; ++r) if (kb2 * 32 + (r & 3) + 8 * (r >> 2) > qrel) st[kb2][r] = -1e30f; } \
            float rs = 0.f; \
            _Pragma("unroll") for (int kb2 = 0; kb2 < 2; ++kb2) _Pragma("unroll") for (int r = 0; r < 16; ++r) { const float p = ex2(st[kb2][r]); st[kb2][r] = p; rs += p; } \
            lrun += rs; \
            _Pragma("unroll") for (int ks = 0; ks < 4; ++ks) { const int kb2 = ks >> 1, r0 = (ks & 1) * 8; pf[ks] = pack8(st[kb2][r0], st[kb2][r0 + 1], st[kb2][r0 + 2], st[kb2][r0 + 3], st[kb2][r0 + 4], st[kb2][r0 + 5], st[kb2][r0 + 6], st[kb2][r0 + 7]); } \
            ATT_H2B(); } } while (0)
#define ATT_VF(i) tr_frag(Vb_ + troffV + 16 * ((i) >> 2) * RV + ((i) & 3) * 64, 8 * RV)
#define ATT_H2A(sbase) const lds_u8* Vb_ = (sbase) + 2 * 64 * RK; bf16x8 vf0_ = ATT_VF(0), vf1_ = ATT_VF(1), vf2_ = ATT_VF(2), vf3_ = ATT_VF(3)
#define ATT_H2B() do { _Pragma("unroll") for (int i_ = 0; i_ < 16; i_ += 4) { \
                o[0] = MFMA32(vf0_, pf[i_ >> 2], o[0]); if (i_ + 4 < 16) vf0_ = ATT_VF(i_ + 4); \
                o[1] = MFMA32(vf1_, pf[i_ >> 2], o[1]); if (i_ + 5 < 16) vf1_ = ATT_VF(i_ + 5); \
                o[2] = MFMA32(vf2_, pf[i_ >> 2], o[2]); if (i_ + 6 < 16) vf2_ = ATT_VF(i_ + 6); \
                o[3] = MFMA32(vf3_, pf[i_ >> 2], o[3]); if (i_ + 7 < 16) vf3_ = ATT_VF(i_ + 7); } } while (0)
        asm volatile("" :: "v"(qf[0]), "v"(qf[1]), "v"(qf[2]), "v"(qf[3]));
        __syncthreads();
        ATT_DMA(0, 0);
        if (ntile > 1) ATT_DMA(1, 1);
        int scur = 0;
        for (int it = 0; it < ntile; ++it) {
            if (it + 1 < ntile) asm volatile("s_waitcnt vmcnt(5)" ::: "memory"); else asm volatile("s_waitcnt vmcnt(0)" ::: "memory");
            __builtin_amdgcn_s_barrier(); asm volatile("" ::: "memory");
            const int snext2 = scur == 0 ? 2 : scur - 1;
            if (it + 2 < ntile) ATT_DMA(it + 2, snext2);
            if ((kt0 + it) * 64 <= qw + 31) { const lds_u8* sb = lds + scur * STG3; ATT_TILE(it, sb); }
            scur = scur == 2 ? 0 : scur + 1;
        }
        asm volatile("s_waitcnt vmcnt(0)" ::: "memory");
        __syncthreads();
#undef ATT_DMA
#undef ATT_TILE
#undef ATT_H2A
#undef ATT_H2B
#undef ATT_VF
        lrun += __shfl_xor(lrun, 32);
        const float inv = 1.0f / lrun;
        LAS f32x4* Xs = (LAS f32x4*)lds;
        if (map == 1) {
#pragma unroll
            for (int db = 0; db < 4; ++db)
#pragma unroll
                for (int rq = 0; rq < 4; ++rq) Xs[(qs * 16 + db * 4 + rq) * 64 + lane] = (f32x4){o[db][4 * rq] * inv, o[db][4 * rq + 1] * inv, o[db][4 * rq + 2] * inv, o[db][4 * rq + 3] * inv};
        }
        __syncthreads();
        if (map == 0) {
            float ss = 0.f;
#pragma unroll
            for (int db = 0; db < 4; ++db)
#pragma unroll
                for (int rq = 0; rq < 4; ++rq) { const f32x4 x2 = Xs[(qs * 16 + db * 4 + rq) * 64 + lane];
#pragma unroll
                    for (int j = 0; j < 4; ++j) { const float d = o[db][4 * rq + j] * inv - lam * x2[j]; o[db][4 * rq + j] = d; ss += d * d; } }
            ss += __shfl_xor(ss, 32);
            const float rstd = (1.0f - lambda_init) / sqrtf(ss * (1.0f / 128.0f) + EPS);
            lds_u8* Os = lds + 65536 + qs * (32 * 272);
#pragma unroll
            for (int db = 0; db < 4; ++db)
#pragma unroll
                for (int rq = 0; rq < 4; ++rq) { const int dv = db * 32 + 8 * rq + 4 * hh; const f32x4 sg = *(const f32x4*)(a.in[I_SUBG] + layer * 128 + dv);
                    const v2u w = {pk2(o[db][4 * rq] * rstd * sg[0], o[db][4 * rq + 1] * rstd * sg[1]), pk2(o[db][4 * rq + 2] * rstd * sg[2], o[db][4 * rq + 3] * rstd * sg[3])};
                    *(LAS v2u*)(Os + l31 * 272 + dv * 2) = w; }
            asm volatile("" ::: "memory");
#pragma unroll
            for (int i = 0; i < 8; ++i) { const int cid = lane + 64 * i, row = cid >> 4, cc = cid & 15;
                *(v4u*)((unsigned char*)ycat + pg8::sub_off(row0 + qw + row, 2560 + hd * 128 + cc * 8, D)) = *(const LAS v4u*)(Os + row * 272 + cc * 16); }
        }
    }
}
__device__ __forceinline__ void stagger_start(int bx, unsigned step_ticks  ) {
    const unsigned long long t0 = __builtin_amdgcn_s_memrealtime(); const unsigned long long wait = (unsigned long long)(((unsigned)bx >> 3) & 3u) * step_ticks;
    while (__builtin_amdgcn_s_memrealtime() - t0 < wait) __builtin_amdgcn_s_sleep(8);
}
constexpr int N_PHASES = 1 + 9 * NLAYER;
#ifndef MK_ONE_LAUNCH
#define MK_ONE_LAUNCH 1
#endif
__global__ void __launch_bounds__(NWAVES * 64, 2) fwd_kernel(Args args) {
    extern __shared__ __attribute__((aligned(16))) unsigned char lds_raw[];
    lds_u8* lds = (lds_u8*)lds_raw;
    volatile LAS unsigned* MISC = (volatile LAS unsigned*)(lds + MISC_OFF);
    const int tid0 = threadIdx.x;
    const int wave_s = __builtin_amdgcn_readfirstlane(tid0 >> 6);
#define MK_TID(var) int var; asm volatile("v_mbcnt_lo_u32_b32 %0, -1, 0\n\tv_mbcnt_hi_u32_b32 %0, -1, %0" : "=v"(var)); var += wave_s * 64
    const int G = gridDim.x, bx = blockIdx.x;
    const int vcu = (G % 8 == 0) ? (bx % 8) * (G / 8) + bx / 8 : bx;
    const int NGW = G * NWAVES;
#if defined(PROBE_ZERO_LDS)
    for (int u = tid0; u < LDSCTL_OFF / 4; u += NWAVES * 64) ((LAS unsigned*)lds)[u] = 0u;
#endif
    for (int u = tid0; u < (LDS_BYTES - LDSCTL_OFF) / 4; u += NWAVES * 64) ((LAS unsigned*)(lds + LDSCTL_OFF))[u] = 0u;
    __syncthreads();
    unsigned* ctl = (unsigned*)(args.ws + WS_CTL);
    XcdBarrier bar; bar.bar = ctl + CW_BAR; bar.x = 0; bar.st = nullptr;
    const int lo = args.ph_lo, hi = args.ph_hi;
    if (hi - lo > 1) bar = xcd_barrier_post(ctl + CW_BAR, MISC + 8);
#if defined(PROBE_CLK)
    if (blockIdx.x == 0 && tid0 == 0) __hip_atomic_store((unsigned long long*)(args.ws + WS_CTL + 524288) + 100, (unsigned long long)__builtin_amdgcn_s_memtime(), __ATOMIC_RELAXED, __HIP_MEMORY_SCOPE_AGENT);
#endif
#if defined(PROBE_CLK)
    if (blockIdx.x == 0 && tid0 == 0) __hip_atomic_store((unsigned long long*)(args.ws + WS_CTL + 524288) + 100, (unsigned long long)__builtin_amdgcn_s_memtime(), __ATOMIC_RELAXED, __HIP_MEMORY_SCOPE_AGENT);
#endif
#ifndef PROBE_DUP
#define PROBE_DUP 0
#endif
#define DUPN(j) ((((PROBE_DUP) >> (j)) & 1) ? 2 : 1)
#if defined(PROBE_AMP)
#define STAMP(slot) do { { __syncthreads(); if (wave_s == 0) { MK_TID(ts_); if (ts_ == 0) __hip_atomic_store((unsigned long long*)(args.ws + WS_CTL + 524288) + bx * 64 + (slot), (unsigned long long)__builtin_amdgcn_s_memrealtime(), __ATOMIC_RELAXED, __HIP_MEMORY_SCOPE_AGENT); } } } while (0)
#else
#define STAMP(slot) do { } while (0)
#endif
#ifndef PG8_SP2
#define PG8_SP2 true
#endif
#ifndef STAG_RESID
#define STAG_RESID 200u
#endif
#ifndef WGM_FFNOUT
#define WGM_FFNOUT 2
#endif
#ifndef WGM_SQ
#define WGM_SQ 4
#endif
#ifndef WGM_WIDE
#define WGM_WIDE 8
#endif
#ifndef PROBE_NULL
#define PROBE_NULL 0
#endif
#ifndef PH_MASK
#define PH_MASK 0xffff
#endif
#define IN(k) (lo <= (k) && (k) < hi)
#define HAS(j) (((PH_MASK) >> (j)) & 1)
#define SEAM(k) do { if (IN(k) && IN((k) + 1)) { XcdBarrier b2_ = bar; asm volatile("" : "+s"(b2_.bar), "+s"(b2_.x));     \
        xcd_barrier(b2_); } } while (0)
    unsigned char* ws = args.ws;
    bf16* XN = (bf16*)(ws + WS_XN); bf16* HID = (bf16*)(ws + WS_HID); bf16* MIXO = (bf16*)(ws + WS_MIXO); bf16* YPRE = (bf16*)(ws + WS_YPRE); bf16* YCAT = (bf16*)(ws + WS_YCAT); bf16* MERGED = (bf16*)(ws + WS_MERGED);

    float* SSQ = (float*)(ws + WS_SSQP);
    static_assert(M / 256 == 64 && pg8::WGM == 8 && pg8::NXCD == 8, "row_scales_phase: a workgroup's units stay inside 8 row panels only for 64 panels / 8 XCD chunks / 8-panel groups");
    const int PM0 = 8 * (bx % 8);
    LAS float* RSL = (LAS float*)(lds + LDSCTL_OFF + 1024);
    const int TAIL0 = ((M / 256) * (2 * FF / 256)) % G;
    bf16* H16 = XN;
    STAMP(40);
    if (HAS(12) && IN(0)) { const int lane = tid0 & 63, wave = __builtin_amdgcn_readfirstlane(tid0 >> 6); for (int dup = 0; dup < DUPN(0); ++dup) conv_phase(args, lds, 0, 0, vcu * NWAVES + wave, NGW, lane, wave);
        for (int dup = 0; dup < DUPN(1); ++dup) cast_phase(args.in[I_X], H16, SSQ, vcu * NWAVES + wave, NGW, lane); }
    STAMP(42);
    SEAM(0);
    STAMP(41);
    for (int l = 0; l < NLAYER; ++l) {
        const int pb = 1 + 9 * l;
        const int wave = wave_s;
        unsigned char* wl = ws + WS_W + (size_t)l * LW_SIZE;
        float* ssq0 = SSQ + (size_t)(l * 3 + 0) * M * 64; float* ssq1 = SSQ + (size_t)(l * 3 + 1) * M * 64; float* ssq2 = SSQ + (size_t)(l * 3 + 2) * M * 64; float* ssq0n = SSQ + (size_t)(l * 3 + 3) * M * 64;
        STAMP(16 * l + 9);
        if (HAS(0) && IN(pb + 0)) { pg8::Gemm g{H16, (const bf16*)(wl + LW_FI0), M, 2 * FF, D}; pg8::StaticOrder S; S.init(M, 2 * FF, G, bx, WGM_WIDE);
            { MK_TID(t0); pg8::row_scales_phase(ssq0, 1.0f / D, EPS, RSL, PM0, t0); } pg8::EpiSwiglu E{HID, FF, ssq0, 1.0f / D, EPS, RSL, PM0};
            if (DUPN(2) == 2 && PROBE_NULL) { pg8::EpiNull E0{HID}; pg8::gemm_phase<pg8::EpiNull, pg8::StaticOrder, true, PG8_SP2>(lds, g, S, E0, wave_s); } else if (DUPN(2) == 2) { pg8::gemm_phase<pg8::EpiSwiglu, pg8::StaticOrder, true, PG8_SP2>(lds, g, S, E, wave_s); }
            pg8::gemm_phase<pg8::EpiSwiglu, pg8::StaticOrder, true, PG8_SP2>(lds, g, S, E, wave_s);
            STAMP(16 * l + 46);
            if (bx >= TAIL0) { MK_TID(t1); conv_phase(args, lds, 1, l, (bx - TAIL0) * NWAVES + wave, (G - TAIL0) * NWAVES, t1 & 63, wave); } }
        STAMP(16 * l + 44);
        if (IN(pb + 0) && hi - lo > 1) { MK_TID(td); conv_drain(args, lds, pb + 0, cv_deadline(l, 0), td, td & 63, wave); }
        SEAM(pb + 0);
        STAMP(16 * l + 10);
        if (HAS(1) && IN(pb + 1)) { pg8::Gemm g{HID, (const bf16*)(wl + LW_FO0), M, D, FF}; pg8::StaticOrder S; S.init(M, D, G, bx, WGM_FFNOUT);
            if (DUPN(3) == 2 && PROBE_NULL) { pg8::EpiNull E0{HID}; pg8::gemm_phase<pg8::EpiNull, pg8::StaticOrder, true, PG8_SP2>(lds, g, S, E0, wave_s); }
            else if (DUPN(3) == 2) { pg8::EpiResid<false, false> E2{H16, YCAT, D, 0.5f, ssq1}; pg8::gemm_phase<pg8::EpiResid<false, false>, pg8::StaticOrder, true, PG8_SP2>(lds, g, S, E2, wave_s); }
            if (l == 0) { pg8::EpiResid<true, false> E{args.in[I_X], H16, D, 0.5f, ssq1}; pg8::gemm_phase<pg8::EpiResid<true, false>, pg8::StaticOrder, true, PG8_SP2>(lds, g, S, E, wave_s); }
            else { pg8::EpiResid<false, false> E{H16, H16, D, 0.5f, ssq1}; pg8::gemm_phase<pg8::EpiResid<false, false>, pg8::StaticOrder, true, PG8_SP2>(lds, g, S, E, wave_s); } }
        if (IN(pb + 1) && hi - lo > 1) { MK_TID(td); conv_drain(args, lds, pb + 1, cv_deadline(l, 1), td, td & 63, wave); }
        SEAM(pb + 1);
        STAMP(16 * l + 11);
        if (HAS(2) && IN(pb + 2)) { pg8::Gemm g{H16, (const bf16*)(wl + LW_MIX), M, NIN, D}; pg8::StaticOrder S; S.init(M, NIN, G, bx, WGM_WIDE); { MK_TID(t2); pg8::row_scales_phase(ssq1, 1.0f / D, EPS, RSL, PM0, t2); } pg8::EpiMix E{MIXO, NIN, C_G / 256, ssq1, 1.0f / D, EPS, RSL, PM0, args.in[I_QG] + l * 64, args.in[I_KG] + l * 64, (LAS float*)(lds + QKX_OFF), C_DQ / 256, C_DK / 256, C_DV / 256};
            for (int dup = 0; dup < DUPN(4); ++dup) { pg8::gemm_phase<pg8::EpiMix, pg8::StaticOrder, true, PG8_SP2>(lds, g, S, E, wave_s); } }
        STAMP(16 * l + 47);
        if (IN(pb + 2) && hi - lo > 1) { MK_TID(td); conv_drain(args, lds, pb + 2, cv_deadline(l, 2), td, td & 63, wave); }
        SEAM(pb + 2);
        if (HAS(3) && IN(pb + 3)) {
            MK_TID(t3); const int lane = t3 & 63;
            STAMP(16 * l + 0);
            if (HAS(13)) for (int dup = 0; dup < DUPN(5); ++dup) ssm_phase(args, l, lds, lane, wave, bx, G);
            STAMP(16 * l + 1);
            asm volatile("s_waitcnt vmcnt(0)" ::: "memory"); __syncthreads();
            { MK_TID(ts); if (ts == 0 && bx < NB * 64) { __builtin_amdgcn_fence(__ATOMIC_RELEASE, "agent"); asm volatile("s_waitcnt vmcnt(0)" ::: "memory");
                (void)__hip_atomic_fetch_add(ctl + CW_SSMF + 64 * l, (unsigned)((NB * 64 - bx + G - 1) / G), __ATOMIC_RELAXED, __HIP_MEMORY_SCOPE_AGENT); } }
            STAMP(16 * l + 2); STAMP(16 * l + 3); }
        if (IN(pb + 3) && !IN(pb + 4)) { }
        STAMP(16 * l + 4);
        if (HAS(4) && IN(pb + 4)) { { MK_TID(tr); ret_state_phase(args, l, lds, tr, tr & 63, wave); }
            { MK_TID(ta); if (HAS(13)) for (int dup = 0; dup < DUPN(7); ++dup) attn_phase(args, l, lds, ta, ta & 63, wave); }
            __syncthreads(); STAMP(16 * l + 5); { MK_TID(tb); ret_state_wait(args, l, tb); if (HAS(14)) for (int dup = 0; dup < DUPN(8); ++dup) ret_out_phase(args, lds, tb, tb & 63, wave); } __syncthreads(); STAMP(16 * l + 6);
            { MK_TID(tg); if (tg == 0) { XB_SPIN(xb_ld(ctl + CW_SSMF + 64 * l) < (unsigned)(NB * 64), ctl + CW_BAR); __builtin_amdgcn_fence(__ATOMIC_ACQUIRE, "agent"); asm volatile("s_waitcnt vmcnt(0)" ::: "memory"); } __syncthreads(); }
            if (HAS(15)) { pg8::Gemm g{YPRE, (const bf16*)(wl + LW_GLU), M, 1024, 1024}; pg8::StaticOrder S; S.init(M, 1024, G, bx); pg8::EpiGlu E{YPRE, 1024, YCAT, D, args.in[I_GLUB] + (size_t)l * 1024};
            for (int dup = 0; dup < DUPN(9); ++dup) { pg8::gemm_phase<pg8::EpiGlu, pg8::StaticOrder, true, PG8_SP2>(lds, g, S, E, wave_s); } } }
        STAMP(16 * l + 7);
        if (IN(pb + 4) && hi - lo > 1) { MK_TID(td); conv_drain(args, lds, pb + 4, cv_deadline(l, 4), td, td & 63, wave); }
        SEAM(pb + 4);
        STAMP(16 * l + 8);
#if defined(PROBE_ATTN2)
        if (IN(pb + 5)) { MK_TID(tz); attn_phase(args, l, lds, tz, tz & 63, wave); __syncthreads(); }
#endif
        if (HAS(5) && IN(pb + 5)) { pg8::Gemm g{YCAT, (const bf16*)(wl + LW_BR), M, D, D}; pg8::StaticOrder S; S.init(M, D, G, bx, WGM_SQ); pg8::EpiBranch E{MIXO + C_G, NIN, MERGED, D};
            for (int dup = 0; dup < DUPN(10); ++dup) { pg8::gemm_phase<pg8::EpiBranch, pg8::StaticOrder, true, PG8_SP2>(lds, g, S, E, wave_s); } }
        if (IN(pb + 5) && hi - lo > 1) { MK_TID(td); conv_drain(args, lds, pb + 5, cv_deadline(l, 5), td, td & 63, wave); }
        SEAM(pb + 5);
        STAMP(16 * l + 13);
        if (HAS(6) && IN(pb + 6)) { pg8::Gemm g{MERGED, (const bf16*)(wl + LW_OUT), M, D, D}; pg8::StaticOrder S; S.init(M, D, G, bx, WGM_SQ); pg8::EpiResid<false, false> E{H16, H16, D, 1.0f, ssq2};
            pg8::gemm_phase<pg8::EpiResid<false, false>, pg8::StaticOrder, true, PG8_SP2>(lds, g, S, E, wave_s); }
        if (IN(pb + 6) && hi - lo > 1) { MK_TID(td); conv_drain(args, lds, pb + 6, cv_deadline(l, 6), td, td & 63, wave); }
        SEAM(pb + 6);
        STAMP(16 * l + 14);
        if (HAS(7) && IN(pb + 7)) { pg8::Gemm g{H16, (const bf16*)(wl + LW_FI1), M, 2 * FF, D}; pg8::StaticOrder S; S.init(M, 2 * FF, G, bx, WGM_WIDE); { MK_TID(t7); pg8::row_scales_phase(ssq2, 1.0f / D, EPS, RSL, PM0, t7); } pg8::EpiSwiglu E{HID, FF, ssq2, 1.0f / D, EPS, RSL, PM0};
            if (DUPN(2) == 2 && PROBE_NULL) { pg8::EpiNull E0{HID}; pg8::gemm_phase<pg8::EpiNull, pg8::StaticOrder, true, PG8_SP2>(lds, g, S, E0, wave_s); } else if (DUPN(2) == 2) { pg8::gemm_phase<pg8::EpiSwiglu, pg8::StaticOrder, true, PG8_SP2>(lds, g, S, E, wave_s); }
            pg8::gemm_phase<pg8::EpiSwiglu, pg8::StaticOrder, true, PG8_SP2>(lds, g, S, E, wave_s);
            if (bx >= TAIL0) { MK_TID(t8); conv_phase(args, lds, 2, l, (bx - TAIL0) * NWAVES + wave, (G - TAIL0) * NWAVES, t8 & 63, wave); } }
        STAMP(16 * l + 45);
        if (IN(pb + 7) && hi - lo > 1 && l + 1 < NLAYER) { MK_TID(td); conv_drain(args, lds, pb + 7, cv_deadline(l, 7), td, td & 63, wave); }
        SEAM(pb + 7);
        STAMP(16 * l + 15);
        if (HAS(8) && IN(pb + 8)) { pg8::Gemm g{HID, (const bf16*)(wl + LW_FO1), M, D, FF}; pg8::StaticOrder S; S.init(M, D, G, bx, WGM_FFNOUT);
            if (DUPN(3) == 2 && PROBE_NULL) { pg8::EpiNull E0{HID}; pg8::gemm_phase<pg8::EpiNull, pg8::StaticOrder, true, PG8_SP2>(lds, g, S, E0, wave_s); }
            else if (DUPN(3) == 2) { pg8::EpiResid<false, false> E2{H16, YCAT, D, 0.5f, ssq0n}; pg8::gemm_phase<pg8::EpiResid<false, false>, pg8::StaticOrder, true, PG8_SP2>(lds, g, S, E2, wave_s); }
            if (l + 1 < NLAYER) { pg8::EpiResid<false, false> E{H16, H16, D, 0.5f, ssq0n}; pg8::gemm_phase<pg8::EpiResid<false, false>, pg8::StaticOrder, true, PG8_SP2>(lds, g, S, E, wave_s); }
            else { pg8::EpiResid<false, true> E{H16, args.out, D, 0.5f, nullptr}; pg8::gemm_phase<pg8::EpiResid<false, true>, pg8::StaticOrder, true, PG8_SP2>(lds, g, S, E, wave_s); } }
        if (IN(pb + 8) && hi - lo > 1 && l + 1 < NLAYER) { MK_TID(td); conv_drain(args, lds, pb + 8, cv_deadline(l, 8), td, td & 63, wave); }
        SEAM(pb + 8);
        STAMP(16 * l + 12);
    }
#if defined(PROBE_CLK)
    if (bx == 0 && hi - lo > 1) { __syncthreads(); if (wave_s == 0) { MK_TID(te_); if (te_ == 0) {
        const unsigned long long dc_ = (unsigned long long)__builtin_amdgcn_s_memtime() - __hip_atomic_load((unsigned long long*)(args.ws + WS_CTL + 524288) + 100, __ATOMIC_RELAXED, __HIP_MEMORY_SCOPE_AGENT);
        const unsigned long long t0_ = __builtin_amdgcn_s_memrealtime(); while (__builtin_amdgcn_s_memrealtime() - t0_ < dc_ / 64) __builtin_amdgcn_s_sleep(8); } } __syncthreads(); }
#endif
#if defined(PROBE_CLK)
    if (bx == 0 && hi - lo > 1) { __syncthreads(); if (wave_s == 0) { MK_TID(te_); if (te_ == 0) {
        const unsigned long long dc_ = (unsigned long long)__builtin_amdgcn_s_memtime() - __hip_atomic_load((unsigned long long*)(args.ws + WS_CTL + 524288) + 100, __ATOMIC_RELAXED, __HIP_MEMORY_SCOPE_AGENT);
        const unsigned long long t0_ = __builtin_amdgcn_s_memrealtime(); while (__builtin_amdgcn_s_memrealtime() - t0_ < dc_ / 64) __builtin_amdgcn_s_sleep(8); } } __syncthreads(); }
#endif
#if defined(PROBE_AMP)
    if (hi - lo > 1 && bx == ((PROBE_WG) >= 0 ? (PROBE_WG) : 0)) { __syncthreads(); if (wave_s == 0) { MK_TID(te_);
        unsigned long long* sp_ = (unsigned long long*)(args.ws + WS_CTL + 524288); unsigned long long wait_ = 0;
        if ((PROBE_WG) >= 0) { for (int l = 0; l < NLAYER; ++l) wait_ += __hip_atomic_load(sp_ + bx * 64 + 16 * l + (PROBE_B), __ATOMIC_RELAXED, __HIP_MEMORY_SCOPE_AGENT) - __hip_atomic_load(sp_ + bx * 64 + 16 * l + (PROBE_A), __ATOMIC_RELAXED, __HIP_MEMORY_SCOPE_AGENT);
            wait_ *= (PROBE_AMP); }
        else { for (int l = 0; l < ((PROBE_WG) == -2 ? 1 : NLAYER); ++l) { const unsigned long long base_ = __hip_atomic_load(sp_ + 16 * l + (PROBE_B), __ATOMIC_RELAXED, __HIP_MEMORY_SCOPE_AGENT);
                int mx_ = -(1 << 30), sm_ = 0, am_ = 0;
                for (int k = 0; k < 4; ++k) { const int w_ = ((PROBE_WG) == -4) ? ((te_ * 4 + k) * 8 + (PROBE_A)) : te_ * 4 + k; const int r_ = (w_ < G) ? (int)(long long)(__hip_atomic_load(sp_ + w_ * 64 + 16 * l + (PROBE_B), __ATOMIC_RELAXED, __HIP_MEMORY_SCOPE_AGENT) - base_) : -(1 << 30);
                    if (w_ < G) sm_ += r_; if (r_ > mx_) { mx_ = r_; am_ = w_; } }
                for (int o = 1; o < 64; o <<= 1) { const int m2 = __shfl_xor(mx_, o), a2 = __shfl_xor(am_, o); sm_ += __shfl_xor(sm_, o); if (m2 > mx_ || (m2 == mx_ && a2 < am_)) { mx_ = m2; am_ = a2; } }
                if ((PROBE_WG) == -2) wait_ += (unsigned long long)am_ * 2000ull; else if ((PROBE_WG) == -4) wait_ += (unsigned long long)(PROBE_AMP) * (unsigned long long)(mx_ - sm_ / (G / 8)); else wait_ += (unsigned long long)(PROBE_AMP) * (unsigned long long)(mx_ - sm_ / G); } }
        if (te_ == 0) { const unsigned long long t0_ = __builtin_amdgcn_s_memrealtime(); while (__builtin_amdgcn_s_memrealtime() - t0_ < wait_) __builtin_amdgcn_s_sleep(8); } } __syncthreads(); }
#endif
#undef IN
#undef SEAM
}

extern "C" void kernel_launch(void* const* d_in, const int* in_sizes, int n_in, void* d_out, int out_size, void* d_ws, size_t ws_size, hipStream_t stream) {
    static int grid = 0;
    if (grid == 0) {
        if (n_in != 26 || in_sizes[0] != M * D || out_size != M * D || ws_size < WS_END) { fprintf(stderr, "kernel_launch: unexpected shapes (n_in %d, in0 %d, out %d, ws %zu < %zu); nothing launched\n", n_in, n_in > 0 ? in_sizes[0] : -1, out_size, ws_size, (size_t)WS_END); grid = -1; return; }
        int dev = 0, cus = 0, per_cu = 0;
        if (hipGetDevice(&dev) != hipSuccess || hipDeviceGetAttribute(&cus, hipDeviceAttributeMultiprocessorCount, dev) != hipSuccess) { grid = -1; return; }
        if (hipFuncSetAttribute((const void*)fwd_kernel, hipFuncAttributeMaxDynamicSharedMemorySize, LDS_BYTES) != hipSuccess) { fprintf(stderr, "kernel_launch: hipFuncSetAttribute failed\n"); grid = -1; return; }
        if (hipOccupancyMaxActiveBlocksPerMultiprocessor(&per_cu, (const void*)fwd_kernel, NWAVES * 64, LDS_BYTES) != hipSuccess || per_cu < 1) { fprintf(stderr, "kernel_launch: occupancy query says %d workgroups per CU\n", per_cu); }
        (void)hipGetLastError();
        grid = cus;
        if (grid % 8 != 0) { fprintf(stderr, "kernel_launch: %d CUs: this kernel's unit order needs a multiple of 8 workgroups; nothing launched\n", grid); grid = -1; return; }
    }
    if (grid < 0) return;
    if (hipMemsetAsync((char*)d_ws + WS_CTL, 0, CTL_ZERO_BYTES, stream) != hipSuccess) return;
    Args a{};
    for (int i = 0; i < 26; ++i) a.in[i] = (const float*)d_in[i];
    a.out = (float*)d_out; a.ws = (unsigned char*)d_ws;
#if MK_ONE_LAUNCH
    a.ph_lo = 0; a.ph_hi = N_PHASES;
    hipLaunchKernelGGL(fwd_kernel, dim3(grid), dim3(NWAVES * 64), LDS_BYTES, stream, a);
#else
    for (int p = 0; p < N_PHASES; ++p) { a.ph_lo = p; a.ph_hi = p + 1; hipLaunchKernelGGL(fwd_kernel, dim3(grid), dim3(NWAVES * 64), LDS_BYTES, stream, a); }
#endif
}
```

```cpp
#include <hip/hip_runtime.h>
#include <cstdio>
#include <cstdint>
namespace pg8 {
#define PG8_LAS __attribute__((address_space(3)))
typedef unsigned short bf16_t;
typedef short bf16x8 __attribute__((ext_vector_type(8)));
typedef float f32x4 __attribute__((ext_vector_type(4)));
typedef unsigned u32x4 __attribute__((ext_vector_type(4)));
constexpr int BM = 256, BK = 64, HALF = 128, HTB = HALF * BK * 2  , STAGE_BYTES = 8 * HTB, NXCD = 8, WGM = 8;

__host__ __device__ __forceinline__ int lds_byte(int r, int c) { const int st = (r >> 4) * 2 + (c >> 5), rr = r & 15, cc = c & 31, ob = rr * 64 + cc * 2; return st * 1024 + (ob ^ (((ob >> 9) & 1) << 5)); }
__host__ __device__ __forceinline__ void stage_rc(int b, int& R, int& C) { const int st = b / 1024, sb = b % 1024, swz = sb ^ (((sb >> 9) & 1) << 5); R = (st >> 1) * 16 + swz / 64; C = (st & 1) * 32 + (swz % 64) / 2; }
__host__ __device__ __forceinline__ int perm32(int rho) { const int n = rho >> 4, i = rho & 15; return 8 * (i >> 2) + 4 * n + (i & 3); }

struct Unit { int pm, pn; };
struct Gemm { const bf16_t* A; const bf16_t* Bt; int M, N, K; };

struct StaticOrder {
    int nM, nN, nwg, G, c, wgm;
    __host__ __device__ void init(int M, int N, int G_, int c_, int wgm_ = WGM) { nM = M / BM; nN = N / BM; nwg = nM * nN; G = G_; c = c_; wgm = wgm_; }
    __host__ __device__ bool next(int i, Unit& u) const {
        const long L = (long)i * G + c; if (L >= nwg) return false;
        int wgid = (int)L; { const int q = nwg / NXCD, r = nwg % NXCD, xcd = wgid % NXCD, off = wgid / NXCD; wgid = (xcd < r ? xcd * (q + 1) : r * (q + 1) + (xcd - r) * q) + off; }
        const int nig = wgm * nN, gid = wgid / nig, fm = gid * wgm, gsz = (nM - fm) < wgm ? (nM - fm) : wgm;
        u.pm = fm + ((wgid % nig) % gsz); u.pn = (wgid % nig) / gsz; return true;
    }
    __device__ __forceinline__ void a_ready(const Unit&) const {}
    __device__ __forceinline__ void done(const Unit&) const {}
};

typedef float f32x2_t __attribute__((ext_vector_type(2))); typedef __bf16 bf16x2_t __attribute__((ext_vector_type(2)));
__device__ __forceinline__ unsigned cvt_pk_bf16(float lo, float hi) { const f32x2_t v = {lo, hi}; const bf16x2_t b = __builtin_convertvector(v, bf16x2_t); return __builtin_bit_cast(unsigned, b); }
__host__ __device__ __forceinline__ size_t sub_off(size_t r, int c, int K) {
    return (((r >> 7) * (size_t)(K >> 6) + (size_t)(c >> 6)) << 14) + (((r >> 4) & 7) << 11) + (size_t)(((c >> 5) & 1) << 10) + ((r & 15) << 6) + (size_t)((c & 31) << 1); }
__device__ __forceinline__ float bf_lo(unsigned w) { return __uint_as_float(w << 16); }
__device__ __forceinline__ float bf_hi(unsigned w) { return __uint_as_float(w & 0xffff0000u); }
__device__ __forceinline__ float sigm(float v) { return __builtin_amdgcn_rcpf(1.0f + __builtin_amdgcn_exp2f(-1.4426950408889634f * v)); }


__device__ __forceinline__ void row_scales_phase(const float* ssq, float inv_d, float eps, PG8_LAS float* rsl, int pm0, int tid) {
    for (int row = tid; row < 8 * BM; row += 512) {
        const f32x4* sp = (const f32x4*)(ssq + ((size_t)pm0 * BM + row) * 64);
        f32x4 s4 = sp[0];
#pragma unroll
        for (int q = 1; q < 16; ++q) s4 += sp[q];
        rsl[row] = 1.0f / sqrtf(((s4[0] + s4[1]) + (s4[2] + s4[3])) * inv_d + eps);
    }
    __syncthreads();
}
struct EpiNull {
    static constexpr bool PERM = true, AFTER_DRAIN = false, MID = false; static constexpr int T0 = -1, T1 = -1;
    bf16_t* O;
    __device__ __forceinline__ void mid(f32x4 (&acc)[2][2][4][2], const Unit& u, int t, int wr, int wc, int fr, int fq) const {}
    __device__ __forceinline__ void operator()(const f32x4 (&acc)[2][2][4][2], const Unit& u, int wr, int wc, int fr, int fq) const {
        float s = 0.f;
#pragma unroll
        for (int ai = 0; ai < 2; ++ai)
#pragma unroll
            for (int bj = 0; bj < 2; ++bj)
#pragma unroll
                for (int m = 0; m < 4; ++m)
#pragma unroll
                    for (int n = 0; n < 2; ++n) s += (acc[ai][bj][m][n][0] + acc[ai][bj][m][n][1]) + (acc[ai][bj][m][n][2] + acc[ai][bj][m][n][3]);
        if (s == 1.2345e30f) O[0] = 1;
    }
};
struct EpiSwiglu {
    static constexpr bool PERM = true, AFTER_DRAIN = false, MID = false; static constexpr int T0 = -1, T1 = -1;
    bf16_t* O; int ldc; const float* ssq; float inv_d, eps; PG8_LAS float* rsl; int pm0;
    __device__ __forceinline__ void mid(f32x4 (&acc)[2][2][4][2], const Unit& u, int t, int wr, int wc, int fr, int fq) const {}
    __device__ __forceinline__ void operator()(const f32x4 (&acc)[2][2][4][2], const Unit& u, int wr, int wc, int fr, int fq) const {
        const int row0 = u.pm * BM + wr * 64 + fr, col0 = u.pn * HALF + wc * 32 + 8 * fq;
#pragma unroll
        for (int ai = 0; ai < 2; ++ai)
#pragma unroll
            for (int m = 0; m < 4; ++m) { bf16_t* rowp = (bf16_t*)((char*)O + sub_off((size_t)(row0 + ai * HALF + m * 16), col0, ldc));
                float h[8]; const float rs = ssq ? rsl[(u.pm - pm0) * BM + wr * 64 + ai * HALF + m * 16 + fr] : 1.0f;
#pragma unroll
                for (int n = 0; n < 2; ++n)
#pragma unroll
                    for (int j = 0; j < 4; ++j) { const float g = acc[ai][0][m][n][j] * rs, up = acc[ai][1][m][n][j] * rs; h[n * 4 + j] = g * sigm(g) * up; }
                u32x4 w; w.x = cvt_pk_bf16(h[0], h[1]); w.y = cvt_pk_bf16(h[2], h[3]); w.z = cvt_pk_bf16(h[4], h[5]); w.w = cvt_pk_bf16(h[6], h[7]);
                *(u32x4*)rowp = w; }
    }
};
template <bool BASE_F32, bool OUT_F32> struct EpiResid {
    static constexpr bool PERM = true, AFTER_DRAIN = false, MID = false; static constexpr int T0 = -1, T1 = -1;
    const void* base; void* out; int ldc; float scale; float* ssq;
    __device__ __forceinline__ void mid(f32x4 (&acc)[2][2][4][2], const Unit& u, int t, int wr, int wc, int fr, int fq) const {}
    __device__ __forceinline__ void operator()(const f32x4 (&acc)[2][2][4][2], const Unit& u, int wr, int wc, int fr, int fq) const {
        const int row0 = u.pm * BM + wr * 64 + fr, col0 = u.pn * BM + wc * 32 + 8 * fq;
#pragma unroll
        for (int ai = 0; ai < 2; ++ai)
#pragma unroll
            for (int m = 0; m < 4; ++m) { const size_t off = (size_t)(row0 + ai * HALF + m * 16) * ldc + col0; float ss = 0.f;
                const size_t so = sub_off((size_t)(row0 + ai * HALF + m * 16), col0, ldc);
#pragma unroll
                for (int bj = 0; bj < 2; ++bj) { f32x4 b0, b1;
                    if (BASE_F32) { b0 = *(const f32x4*)((const float*)base + off + bj * HALF); b1 = *(const f32x4*)((const float*)base + off + bj * HALF + 4); }
                    else { const u32x4 w = *(const u32x4*)((const char*)base + so + bj * 32768); b0 = (f32x4){bf_lo(w.x), bf_hi(w.x), bf_lo(w.y), bf_hi(w.y)}; b1 = (f32x4){bf_lo(w.z), bf_hi(w.z), bf_lo(w.w), bf_hi(w.w)}; }
                    const f32x4 o0 = b0 + scale * acc[ai][bj][m][0], o1 = b1 + scale * acc[ai][bj][m][1];
                    if (OUT_F32) { *(f32x4*)((float*)out + off + bj * HALF) = o0; *(f32x4*)((float*)out + off + bj * HALF + 4) = o1; }
                    else { ss += ((o0[0] * o0[0] + o0[1] * o0[1]) + (o0[2] * o0[2] + o0[3] * o0[3])) + ((o1[0] * o1[0] + o1[1] * o1[1]) + (o1[2] * o1[2] + o1[3] * o1[3]));
                        u32x4 w; w.x = cvt_pk_bf16(o0[0], o0[1]); w.y = cvt_pk_bf16(o0[2], o0[3]); w.z = cvt_pk_bf16(o1[0], o1[1]); w.w = cvt_pk_bf16(o1[2], o1[3]);
                        *(u32x4*)((char*)out + so + bj * 32768) = w; } }
                if (!OUT_F32) { ss += __shfl_xor(ss, 16); ss += __shfl_xor(ss, 32); if (fq == 0) ssq[(size_t)(row0 + ai * HALF + m * 16) * 64 + u.pn * 4 + wc] = ss; }
                if (m == 3) asm volatile("" ::: "memory"); }
    }
};
struct EpiMix {
    static constexpr bool PERM = true, AFTER_DRAIN = false, MID = false; static constexpr int T0 = -1, T1 = -1;
    bf16_t* O; int ldc; int gate_pn; const float* ssq; float inv_d, eps; PG8_LAS float* rsl; int pm0;
    const float* qg; const float* kg; PG8_LAS float* xs; int q_pn, k_pn, v_pn;
    __device__ __forceinline__ void mid(f32x4 (&acc)[2][2][4][2], const Unit& u, int t, int wr, int wc, int fr, int fq) const {}
    __device__ __forceinline__ void qk_tile(const f32x4 (&acc)[2][2][4][2], const Unit& u, int wr, int wc, int fr, int fq) const {
        const int row0 = u.pm * BM + wr * 64 + fr, col0 = u.pn * BM + wc * 32 + 8 * fq; const bool isq = u.pn < k_pn; const int wv = wr * 4 + wc;
        const float* gp = (isq ? qg : kg) + 32 * (wc & 1) + 8 * fq; const float gsc = isq ? 0.125f * 1.4426950408889634f : 1.0f;
        const f32x4 g0 = *(const f32x4*)gp * gsc, g1 = *(const f32x4*)(gp + 4) * gsc;
#pragma unroll
        for (int ai = 0; ai < 2; ++ai)
#pragma unroll
            for (int m = 0; m < 4; ++m) { const float rs = rsl[(u.pm - pm0) * BM + wr * 64 + ai * HALF + m * 16 + fr];
#pragma unroll
                for (int bj = 0; bj < 2; ++bj) { const f32x4 v0 = acc[ai][bj][m][0] * rs, v1 = acc[ai][bj][m][1] * rs;
                    float s = v0[0] * v0[0] + v0[1] * v0[1] + v0[2] * v0[2] + v0[3] * v0[3] + v1[0] * v1[0] + v1[1] * v1[1] + v1[2] * v1[2] + v1[3] * v1[3];
                    s += __shfl_xor(s, 16); s += __shfl_xor(s, 32);
                    if (fq == 0) xs[(wv * 16 + (ai * 4 + m) * 2 + bj) * 16 + fr] = s; } }
        asm volatile("s_waitcnt lgkmcnt(0)" ::: "memory"); __builtin_amdgcn_s_barrier(); asm volatile("" ::: "memory");
#pragma unroll
        for (int ai = 0; ai < 2; ++ai)
#pragma unroll
            for (int m = 0; m < 4; ++m) { bf16_t* rowp = O + (size_t)(row0 + ai * HALF + m * 16) * ldc + col0; const float rs = rsl[(u.pm - pm0) * BM + wr * 64 + ai * HALF + m * 16 + fr];
#pragma unroll
                for (int bj = 0; bj < 2; ++bj) { const int ix = ((ai * 4 + m) * 2 + bj) * 16 + fr;
                    const float r = rs * __builtin_amdgcn_rsqf((xs[wv * 256 + ix] + xs[(wv ^ 1) * 256 + ix]) * (1.0f / 64.0f) + eps);
                    const f32x4 v0 = acc[ai][bj][m][0] * r * g0, v1 = acc[ai][bj][m][1] * r * g1;
                    u32x4 w; w.x = cvt_pk_bf16(v0[0], v0[1]); w.y = cvt_pk_bf16(v0[2], v0[3]); w.z = cvt_pk_bf16(v1[0], v1[1]); w.w = cvt_pk_bf16(v1[2], v1[3]);
                    *(u32x4*)(rowp + bj * HALF) = w; } }
    }
    __device__ __forceinline__ void operator()(const f32x4 (&acc)[2][2][4][2], const Unit& u, int wr, int wc, int fr, int fq) const {
        if (u.pn >= q_pn && u.pn < v_pn) { qk_tile(acc, u, wr, wc, fr, fq); return; }
        const int row0 = u.pm * BM + wr * 64 + fr, col0 = u.pn * BM + wc * 32 + 8 * fq; const bool gate = u.pn >= gate_pn;
#pragma unroll
        for (int ai = 0; ai < 2; ++ai)
#pragma unroll
            for (int m = 0; m < 4; ++m) { bf16_t* rowp = O + (size_t)(row0 + ai * HALF + m * 16) * ldc + col0; const float rs = rsl[(u.pm - pm0) * BM + wr * 64 + ai * HALF + m * 16 + fr];
#pragma unroll
                for (int bj = 0; bj < 2; ++bj) { f32x4 v0 = acc[ai][bj][m][0] * rs, v1 = acc[ai][bj][m][1] * rs;
                    if (gate) {
#pragma unroll
                        for (int j = 0; j < 4; ++j) { v0[j] = sigm(fminf(fmaxf(v0[j], -30.f), 30.f)); v1[j] = sigm(fminf(fmaxf(v1[j], -30.f), 30.f)); } }
                    u32x4 w; w.x = cvt_pk_bf16(v0[0], v0[1]); w.y = cvt_pk_bf16(v0[2], v0[3]); w.z = cvt_pk_bf16(v1[0], v1[1]); w.w = cvt_pk_bf16(v1[2], v1[3]);
                    *(u32x4*)(rowp + bj * HALF) = w; } }
    }
};
struct EpiGlu {
    static constexpr bool PERM = true, AFTER_DRAIN = false, MID = false; static constexpr int T0 = -1, T1 = -1;
    const bf16_t* Y; int ldy; bf16_t* O; int ldo; const float* bias;
    __device__ __forceinline__ void mid(f32x4 (&acc)[2][2][4][2], const Unit& u, int t, int wr, int wc, int fr, int fq) const {}
    __device__ __forceinline__ void operator()(const f32x4 (&acc)[2][2][4][2], const Unit& u, int wr, int wc, int fr, int fq) const {
        const int row0 = u.pm * BM + wr * 64 + fr, col0 = u.pn * BM + wc * 32 + 8 * fq;
#pragma unroll
        for (int bj = 0; bj < 2; ++bj) { const f32x4 b0 = *(const f32x4*)(bias + col0 + bj * HALF), b1 = *(const f32x4*)(bias + col0 + bj * HALF + 4);
#pragma unroll
            for (int ai = 0; ai < 2; ++ai)
#pragma unroll
                for (int m = 0; m < 4; ++m) { const int r = row0 + ai * HALF + m * 16;
                    const u32x4 y = *(const u32x4*)((const char*)Y + sub_off((size_t)r, col0 + bj * HALF, ldy));
                    const f32x4 v0 = acc[ai][bj][m][0] + b0, v1 = acc[ai][bj][m][1] + b1;
                    u32x4 w; w.x = cvt_pk_bf16(bf_lo(y.x) * sigm(v0[0]), bf_hi(y.x) * sigm(v0[1])); w.y = cvt_pk_bf16(bf_lo(y.y) * sigm(v0[2]), bf_hi(y.y) * sigm(v0[3]));
                    w.z = cvt_pk_bf16(bf_lo(y.z) * sigm(v1[0]), bf_hi(y.z) * sigm(v1[1])); w.w = cvt_pk_bf16(bf_lo(y.w) * sigm(v1[2]), bf_hi(y.w) * sigm(v1[3]));
                    *(u32x4*)((char*)O + sub_off((size_t)r, col0 + bj * HALF, ldo)) = w; } }
    }
};
struct EpiBranch {
    static constexpr bool PERM = true, AFTER_DRAIN = false, MID = true; static constexpr int T0 = 16, T1 = 40;
    const bf16_t* G; int ldg; bf16_t* O; int ldo;
    __device__ __forceinline__ void mid(f32x4 (&acc)[2][2][4][2], const Unit& u, int t, int wr, int wc, int fr, int fq) const {
        int fr_l = fr, fq_l = fq; asm volatile("" : "+v"(fr_l), "+v"(fq_l));
        const int row0 = u.pm * BM + wr * 64 + fr_l, col0 = u.pn * BM + wc * 32 + 8 * fq_l; const int ga = (t == T0) ? 0 : 4096;
#pragma unroll
        for (int ai = 0; ai < 2; ++ai)
#pragma unroll
            for (int m = 0; m < 4; ++m) { const bf16_t* gp = G + (size_t)(row0 + ai * HALF + m * 16) * ldg + col0 + ga;
#pragma unroll
                for (int bj = 0; bj < 2; ++bj) { const u32x4 a = *(const u32x4*)(gp + bj * HALF), b = *(const u32x4*)(gp + bj * HALF + 4096);
                    f32x4 r0, r1;
                    r0[0] = bf_lo(a.x) * __builtin_amdgcn_rcpf(bf_lo(b.x)); r0[1] = bf_hi(a.x) * __builtin_amdgcn_rcpf(bf_hi(b.x)); r0[2] = bf_lo(a.y) * __builtin_amdgcn_rcpf(bf_lo(b.y)); r0[3] = bf_hi(a.y) * __builtin_amdgcn_rcpf(bf_hi(b.y));
                    r1[0] = bf_lo(a.z) * __builtin_amdgcn_rcpf(bf_lo(b.z)); r1[1] = bf_hi(a.z) * __builtin_amdgcn_rcpf(bf_hi(b.z)); r1[2] = bf_lo(a.w) * __builtin_amdgcn_rcpf(bf_lo(b.w)); r1[3] = bf_hi(a.w) * __builtin_amdgcn_rcpf(bf_hi(b.w));
                    acc[ai][bj][m][0] *= r0; acc[ai][bj][m][1] *= r1; }
                asm volatile("" ::: "memory"); }
    }
    __device__ __forceinline__ void operator()(const f32x4 (&acc)[2][2][4][2], const Unit& u, int wr, int wc, int fr, int fq) const {
        const int row0 = u.pm * BM + wr * 64 + fr, col0 = u.pn * BM + wc * 32 + 8 * fq;
#pragma unroll
        for (int ai = 0; ai < 2; ++ai)
#pragma unroll
            for (int m = 0; m < 4; ++m) { const int r = row0 + ai * HALF + m * 16;
#pragma unroll
                for (int bj = 0; bj < 2; ++bj) { const u32x4 g = *(const u32x4*)(G + (size_t)r * ldg + col0 + bj * HALF + 8192);
                    const f32x4 v0 = acc[ai][bj][m][0], v1 = acc[ai][bj][m][1];
                    u32x4 w; w.x = cvt_pk_bf16(v0[0] * bf_lo(g.x), v0[1] * bf_hi(g.x)); w.y = cvt_pk_bf16(v0[2] * bf_lo(g.y), v0[3] * bf_hi(g.y));
                    w.z = cvt_pk_bf16(v1[0] * bf_lo(g.z), v1[1] * bf_hi(g.z)); w.w = cvt_pk_bf16(v1[2] * bf_lo(g.w), v1[3] * bf_hi(g.w));
                    *(u32x4*)((char*)O + sub_off((size_t)r, col0 + bj * HALF, ldo)) = w; }
                asm volatile("" ::: "memory"); }
    }
};
template <class Epi, class Sched, bool ALIGN_EPI = false, bool SP2 = false>
__device__ __forceinline__ void gemm_phase(PG8_LAS unsigned char* lds, const Gemm g, const Sched& S, const Epi& E, int wave_s  ) {
    int tid_l; asm volatile("v_mbcnt_lo_u32_b32 %0, -1, 0\n\tv_mbcnt_hi_u32_b32 %0, -1, %0" : "=v"(tid_l)); tid_l += wave_s * 64;
    const int tid = tid_l, wid = __builtin_amdgcn_readfirstlane(tid >> 6), lane = tid & 63, wr = wid >> 2, wc = wid & 3, fr = lane & 15, fq = lane >> 4;
    const int K = g.K, nt = K / BK;
    static_assert(Epi::PERM, "the converted weights are stored in LDS-slot (perm32) row order: every epilogue must use the PERM column map");
    unsigned voffA[2], voffB[2];
#pragma unroll
    for (int i = 0; i < 2; ++i) { int R, C; stage_rc(tid * 16 + i * 8192, R, C); const int Rb = Epi::PERM ? ((R & ~31) + perm32(R & 31)) : R;
        (void)Rb; voffB[i] = (unsigned)((R >> 4) * 2048 + (C >> 5) * 1024 + (R & 15) * 64 + (C & 31) * 2); voffA[i] = voffB[i]; }
    const size_t kstep = 16384;
    const size_t kstepB = kstep;
    const size_t hstep = (size_t)HALF * K * 2;
    const size_t tstep = 2 * hstep;
    const unsigned ldsw = (unsigned)wid * 1024u;
    const int aoff = lds_byte(wr * 64 + fr, fq * 8), boff = lds_byte(wc * 32 + fr, fq * 8);
#define PG8_SA(b, h) (((b) * 2 + (h)) * HTB)
#define PG8_SB(b, h) ((4 + (b) * 2 + (h)) * HTB)
#define PG8_STAGE(bufoff, gbase, voff) do { _Pragma("unroll") for (int _i = 0; _i < 2; ++_i) \
        __builtin_amdgcn_global_load_lds((const unsigned*)((const char*)(gbase) + (voff)[_i]), (PG8_LAS unsigned*)(lds + (bufoff) + ldsw + _i * 8192), 16, 0, 0); } while (0)
#define PG8_LDA(dst, b, h) do { _Pragma("unroll") for (int m = 0; m < 4; ++m) _Pragma("unroll") for (int k = 0; k < 2; ++k) dst[m][k] = *(const PG8_LAS bf16x8*)(lds + PG8_SA(b, h) + aoff + m * 2048 + k * 1024); } while (0)
#define PG8_LDB(dst, b, h) do { _Pragma("unroll") for (int n = 0; n < 2; ++n) _Pragma("unroll") for (int k = 0; k < 2; ++k) dst[n][k] = *(const PG8_LAS bf16x8*)(lds + PG8_SB(b, h) + boff + n * 2048 + k * 1024); } while (0)
#define PG8_MMA(ai, bj, At, Bt) do { __builtin_amdgcn_s_setprio(1); _Pragma("unroll") for (int m = 0; m < 4; ++m) _Pragma("unroll") for (int n = 0; n < 2; ++n) _Pragma("unroll") for (int k = 0; k < 2; ++k) \
        acc[ai][bj][m][n] = __builtin_amdgcn_mfma_f32_16x16x32_bf16(Bt[n][k], At[m][k], acc[ai][bj][m][n], 0, 0, 0); __builtin_amdgcn_s_setprio(0); } while (0)
#define PG8_WAIT_V(n) asm volatile("s_waitcnt vmcnt(" #n ")" ::: "memory")
#define PG8_WAIT_L(n) asm volatile("s_waitcnt lgkmcnt(" #n ")" ::: "memory")
#define PG8_BAR __builtin_amdgcn_s_barrier()
#define PG8_SCHED __builtin_amdgcn_sched_barrier(0)
    Unit cur, nxt; int ui = 0;
    if (!S.next(0, cur)) return;
    f32x4 acc[2][2][4][2];
#pragma unroll
    for (int a = 0; a < 2; ++a)
#pragma unroll
        for (int b = 0; b < 2; ++b)
#pragma unroll
            for (int m = 0; m < 4; ++m)
#pragma unroll
                for (int n = 0; n < 2; ++n) acc[a][b][m][n] = (f32x4){0.f, 0.f, 0.f, 0.f};
    bf16x8 At[4][2], B0[2][2], B1[2][2];
    const char* cA = (const char*)g.A + (size_t)cur.pm * tstep; const char* cB = (const char*)g.Bt + (size_t)cur.pn * tstep;
    S.a_ready(cur);
    if constexpr (SP2) {
        PG8_STAGE(PG8_SB(0, 0), cB, voffB); PG8_STAGE(PG8_SB(0, 1), cB + hstep, voffB); PG8_STAGE(PG8_SA(0, 0), cA, voffA); PG8_STAGE(PG8_SA(0, 1), cA + hstep, voffA);
        if (wr == 1) PG8_BAR;
        PG8_WAIT_V(2); PG8_BAR;
        PG8_STAGE(PG8_SB(1, 0), cB + kstepB, voffB); PG8_STAGE(PG8_SA(1, 0), cA + kstep, voffA); PG8_STAGE(PG8_SB(1, 1), cB + hstep + kstepB, voffB);
        PG8_WAIT_V(6); PG8_BAR;
    } else {
        PG8_STAGE(PG8_SB(0, 0), cB, voffB); PG8_STAGE(PG8_SA(0, 0), cA, voffA); PG8_STAGE(PG8_SB(0, 1), cB + hstep, voffB); PG8_STAGE(PG8_SA(0, 1), cA + hstep, voffA);
        if (wr == 1) PG8_BAR;
        PG8_WAIT_V(4); PG8_BAR;
        PG8_STAGE(PG8_SB(1, 0), cB + kstepB, voffB); PG8_STAGE(PG8_SA(1, 0), cA + kstep, voffA); PG8_STAGE(PG8_SB(1, 1), cB + hstep + kstepB, voffB);
        PG8_WAIT_V(6); PG8_BAR;
    }
    for (;;) {
        const bool has_next = S.next(ui + 1, nxt);
        const char* nA = has_next ? (const char*)g.A + (size_t)nxt.pm * tstep : cA; const char* nB = has_next ? (const char*)g.Bt + (size_t)nxt.pn * tstep : cB;
        for (int t = 0; t < nt; t += 2) {
            const bool last = (t == nt - 2);
            const char* a1 = cA + (size_t)(t + 1) * kstep;
            const char* a2 = last ? nA : cA + (size_t)(t + 2) * kstep; const char* b2 = last ? nB : cB + (size_t)(t + 2) * kstepB;
            const char* a3 = a2 + kstep; const char* b3 = b2 + kstepB;
            if (last && has_next) S.a_ready(nxt);
            if constexpr (Epi::MID) { if (t == Epi::T0 || t == Epi::T1) E.mid(acc, cur, t, wr, wc, fr, fq); }
            if constexpr (SP2) {
            PG8_LDB(B0, 0, 0); PG8_LDB(B1, 0, 1); PG8_SCHED; PG8_LDA(At, 0, 0); PG8_STAGE(PG8_SA(1, 1), a1 + hstep, voffA);
            PG8_WAIT_V(8); PG8_WAIT_L(0); PG8_BAR; PG8_MMA(0, 0, At, B0); PG8_MMA(0, 1, At, B1); PG8_BAR; PG8_SCHED;
            PG8_LDA(At, 0, 1); PG8_STAGE(PG8_SB(0, 0), b2, voffB); PG8_STAGE(PG8_SB(0, 1), b2 + hstep, voffB); PG8_STAGE(PG8_SA(0, 0), a2, voffA);
            PG8_WAIT_V(8); PG8_WAIT_L(0); PG8_BAR; PG8_MMA(1, 0, At, B0); PG8_MMA(1, 1, At, B1); PG8_BAR; PG8_SCHED;
            PG8_LDB(B0, 1, 0); PG8_LDB(B1, 1, 1); PG8_SCHED; PG8_LDA(At, 1, 0); PG8_STAGE(PG8_SA(0, 1), a2 + hstep, voffA);
            PG8_WAIT_V(8); PG8_WAIT_L(0); PG8_BAR; PG8_MMA(0, 0, At, B0); PG8_MMA(0, 1, At, B1); PG8_BAR; PG8_SCHED;
            PG8_LDA(At, 1, 1); PG8_STAGE(PG8_SB(1, 0), b3, voffB); PG8_STAGE(PG8_SB(1, 1), b3 + hstep, voffB); PG8_STAGE(PG8_SA(1, 0), a3, voffA);
            PG8_WAIT_V(8); PG8_WAIT_L(0); PG8_BAR; PG8_MMA(1, 0, At, B0); PG8_MMA(1, 1, At, B1); PG8_BAR; PG8_SCHED;
            } else {
            PG8_LDB(B0, 0, 0); PG8_SCHED; PG8_LDA(At, 0, 0); PG8_STAGE(PG8_SA(1, 1), a1 + hstep, voffA);
            PG8_WAIT_L(8); PG8_BAR; PG8_WAIT_L(0); PG8_MMA(0, 0, At, B0); PG8_BAR; PG8_SCHED;
            PG8_LDB(B1, 0, 1); PG8_STAGE(PG8_SB(0, 0), b2, voffB);
            PG8_BAR; PG8_WAIT_L(0); PG8_MMA(0, 1, At, B1); PG8_BAR;
            PG8_LDA(At, 0, 1); PG8_STAGE(PG8_SA(0, 0), a2, voffA);
            PG8_BAR; PG8_WAIT_L(0); PG8_MMA(1, 0, At, B0); PG8_BAR; PG8_SCHED;
            PG8_STAGE(PG8_SB(0, 1), b2 + hstep, voffB);
            PG8_WAIT_V(6); PG8_BAR; PG8_MMA(1, 1, At, B1); PG8_BAR;
            PG8_LDB(B0, 1, 0); PG8_SCHED; PG8_LDA(At, 1, 0); PG8_STAGE(PG8_SA(0, 1), a2 + hstep, voffA);
            PG8_WAIT_L(8); PG8_BAR; PG8_WAIT_L(0); PG8_MMA(0, 0, At, B0); PG8_BAR; PG8_SCHED;
            PG8_LDB(B1, 1, 1); PG8_STAGE(PG8_SB(1, 0), b3, voffB);
            PG8_BAR; PG8_WAIT_L(0); PG8_MMA(0, 1, At, B1); PG8_BAR;
            PG8_LDA(At, 1, 1); PG8_STAGE(PG8_SA(1, 0), a3, voffA);
            PG8_BAR; PG8_WAIT_L(0); PG8_MMA(1, 0, At, B0); PG8_BAR; PG8_SCHED;
            PG8_STAGE(PG8_SB(1, 1), b3 + hstep, voffB);
            PG8_WAIT_V(6); PG8_BAR; PG8_MMA(1, 1, At, B1); PG8_BAR;
            }
        }
        if constexpr (ALIGN_EPI) { if (wr == 0) PG8_BAR; }
        if constexpr (!Epi::AFTER_DRAIN) { E(acc, cur, wr, wc, fr, fq); S.done(cur); }
        if (!has_next) break;
#pragma unroll
        for (int a = 0; a < 2; ++a)
#pragma unroll
            for (int b = 0; b < 2; ++b)
#pragma unroll
                for (int m = 0; m < 4; ++m)
#pragma unroll
                    for (int n = 0; n < 2; ++n) acc[a][b][m][n] = (f32x4){0.f, 0.f, 0.f, 0.f};
        cur = nxt; cA = nA; cB = nB; ++ui;
        if constexpr (ALIGN_EPI) { if (wr == 1) PG8_BAR; }
    }
    PG8_WAIT_V(0);
    if constexpr (!ALIGN_EPI) { if (wr == 0) PG8_BAR; }
    PG8_BAR;
    if constexpr (Epi::AFTER_DRAIN) { E.fused(acc, cur, wr, wc, fr, fq, lds, wid, lane); S.done(cur); }
#undef PG8_SA
#undef PG8_SB
#undef PG8_STAGE
#undef PG8_LDA
#undef PG8_LDB
#undef PG8_MMA
#undef PG8_WAIT_V
#undef PG8_WAIT_L
#undef PG8_BAR
#undef PG8_SCHED
}
}

#define GAS __attribute__((address_space(1)))
#define LAS __attribute__((address_space(3)))
typedef unsigned short bf16;
typedef unsigned v4u __attribute__((ext_vector_type(4)));
typedef unsigned v2u __attribute__((ext_vector_type(2)));
typedef float f32x4 __attribute__((ext_vector_type(4)));
typedef float f32x16 __attribute__((ext_vector_type(16)));
typedef float f32x2v __attribute__((ext_vector_type(2)));
typedef short bf16x8 __attribute__((ext_vector_type(8)));
typedef short v4i16_t __attribute__((ext_vector_type(4)));
typedef GAS unsigned gu32;
#define RLX_AGENT __ATOMIC_RELAXED, __HIP_MEMORY_SCOPE_AGENT
#define LDS_WAIT() asm volatile("s_waitcnt lgkmcnt(0)" ::: "memory")
#define VM_WAIT() asm volatile("s_waitcnt vmcnt(0)" ::: "memory")
__device__ __forceinline__ unsigned pk2(float lo, float hi) { return pg8::cvt_pk_bf16(lo, hi); }
__device__ __forceinline__ float bflo(unsigned w) { return __uint_as_float(w << 16); }
__device__ __forceinline__ float bfhi(unsigned w) { return __uint_as_float(w & 0xffff0000u); }
__device__ __forceinline__ float ex2(float x) { return __builtin_amdgcn_exp2f(x); }
__device__ __forceinline__ float sigm(float v) { return __builtin_amdgcn_rcpf(1.0f + __builtin_amdgcn_exp2f(-1.4426950408889634f * v)); }

#define XB_TMO      128
#define XB_XCNT(j)  (256  + 64 * (j))
#define XB_XSUB(j)  (1280 + 64 * (j))
#define XB_XGEN(j)  (2304 + 64 * (j))
#define XB_TOP      3328
#define XB_TOPGEN   3392
#define XCD_BAR_WORDS 3456
#define XB_SPIN_CAP (1u << 18)

__device__ __forceinline__ unsigned xb_ld(unsigned* p)              { return __hip_atomic_load(p, __ATOMIC_RELAXED, __HIP_MEMORY_SCOPE_AGENT); }
__device__ __forceinline__ unsigned xb_add(unsigned* p, unsigned v) { return __hip_atomic_fetch_add(p, v, __ATOMIC_RELAXED, __HIP_MEMORY_SCOPE_AGENT); }
__device__ __forceinline__ unsigned xb_xcc_id() { return (unsigned)__builtin_amdgcn_s_getreg((3 << 11) | 20) & 0xFu; }
#define XB_SPIN(cond, bar) do { unsigned _sp = 0; while (cond) { __builtin_amdgcn_s_sleep(1); \
    if ((++_sp & 255u) == 0u) { if (xb_ld(&(bar)[XB_TMO])) break; if (_sp > XB_SPIN_CAP) { atomicAdd(&(bar)[XB_TMO], 1u); break; } } } } while (0)

struct XcdBarrier {
    unsigned* bar; unsigned x;
    volatile LAS unsigned* st;
};

__device__ __forceinline__ XcdBarrier xcd_barrier_post(unsigned* bar, volatile LAS unsigned* st) {
    XcdBarrier b; b.bar = bar; b.x = xb_xcc_id(); b.st = st;
    if (threadIdx.x == 0) (void)xb_add(&bar[XB_XCNT(b.x)], 1u);
    return b;
}
__device__ __forceinline__ void xcd_barrier_complete(unsigned* bar, unsigned x, unsigned& nloc, unsigned& nx) {
    const unsigned G = gridDim.x * gridDim.y * gridDim.z;
    unsigned sum, cnt, mine, sp = 0u;
    for (;;) {
        sum = 0u; cnt = 0u; mine = 0u;
#pragma unroll
        for (unsigned j = 0; j < 16; ++j) { const unsigned c = xb_ld(&bar[XB_XCNT(j)]); sum += c; cnt += (c > 0u) ? 1u : 0u; mine = (j == x) ? c : mine; }
        if (sum == G) break;
        __builtin_amdgcn_s_sleep(1);
        if ((++sp & 255u) == 0u) { if (xb_ld(&bar[XB_TMO])) break; if (sp > XB_SPIN_CAP) { atomicAdd(&bar[XB_TMO], 1u); break; } }
    }
    nloc = mine > 0u ? mine : 1u; nx = cnt > 0u ? cnt : 1u;
}

__device__ __forceinline__ void xcd_barrier(const XcdBarrier& b) {
    asm volatile("s_waitcnt vmcnt(0)" ::: "memory");
    __syncthreads();
    if (threadIdx.x == 0) {
        unsigned* bar = b.bar;
        __builtin_amdgcn_s_waitcnt(0);
        unsigned nloc = b.st[0], nx = b.st[1];
        if (nloc == 0u) { xcd_barrier_complete(bar, b.x, nloc, nx); b.st[0] = nloc; b.st[1] = nx; }
        const unsigned old = xb_add(&bar[XB_XSUB(b.x)], 1u);
        const unsigned gen = old / nloc;
        if (old + 1u == (gen + 1u) * nloc) {
            __builtin_amdgcn_fence(__ATOMIC_RELEASE, "agent");
            asm volatile("s_waitcnt vmcnt(0)" ::: "memory");
            const unsigned og = xb_add(&bar[XB_TOP], 1u);
            const unsigned tg = og / nx;
            if (og + 1u == (tg + 1u) * nx) xb_add(&bar[XB_TOPGEN], 1u);
            else XB_SPIN(xb_ld(&bar[XB_TOPGEN]) == tg, bar);
            __builtin_amdgcn_fence(__ATOMIC_ACQUIRE, "agent");
            xb_add(&bar[XB_XGEN(b.x)], 1u);
            asm volatile("s_waitcnt vmcnt(0)" ::: "memory");
        } else {
            XB_SPIN(xb_ld(&bar[XB_XGEN(b.x)]) == gen, bar);
            __builtin_amdgcn_fence(__ATOMIC_ACQUIRE, "agent");
            asm volatile("s_waitcnt vmcnt(0)" ::: "memory");
        }
    }
    __syncthreads();
}


constexpr int NB = 4, SEQ = 4096, D = 4096, M = NB * SEQ, FF = 11008, NIN = 22528, NLAYER = 2, NWAVES = 8;
constexpr int C_U = 0, C_RQ = 1024, C_RK = 1792, C_RV = 2560, C_RG = 4096, C_DQ = 5632, C_DK = 7168, C_DV = 8704, C_G = 10240;
constexpr float EPS = 1e-6f, LOG2E = 1.4426950408889634f;
constexpr size_t MiB = 1u << 20;
constexpr size_t WS_CTL = 0, CTL_ZERO_BYTES = 1 * MiB;
constexpr int CW_BAR = 4096;
constexpr int CW_SSMF = 12288 + 2048;
constexpr int CW_RSF = 12288;
constexpr int CW_ATTQ = 16384;
constexpr size_t SZ_WFI = (size_t)2 * FF * D * 2, SZ_WFO = (size_t)D * FF * 2, SZ_WMIX = (size_t)NIN * D * 2, SZ_WGLU = (size_t)1024 * 1024 * 2, SZ_WBR = (size_t)D * D * 2, SZ_WOUT = (size_t)D * D * 2;
constexpr size_t LW_FI0 = 0, LW_FO0 = LW_FI0 + SZ_WFI, LW_MIX = LW_FO0 + SZ_WFO, LW_GLU = LW_MIX + SZ_WMIX, LW_BR = LW_GLU + SZ_WGLU, LW_OUT = LW_BR + SZ_WBR, LW_FI1 = LW_OUT + SZ_WOUT, LW_FO1 = LW_FI1 + SZ_WFI, LW_SIZE = LW_FO1 + SZ_WFO;
constexpr size_t WS_W = 2 * MiB;
constexpr size_t WS_XN = WS_W + NLAYER * LW_SIZE;
constexpr size_t WS_HID = WS_XN + (size_t)M * D * 2;
constexpr size_t WS_MIXO = WS_HID + (size_t)M * FF * 2;
constexpr size_t WS_YPRE = WS_MIXO + (size_t)M * NIN * 2;
constexpr size_t WS_YCAT = WS_YPRE + (size_t)M * 1024 * 2;
constexpr size_t WS_MERGED = WS_YCAT + (size_t)M * D * 2;
constexpr size_t WS_PREVT = WS_MERGED + (size_t)M * D * 2;
constexpr size_t WS_SSQP = WS_PREVT + (size_t)NB * 6 * 32 * 256 * 128 * 2;
constexpr size_t WS_END = WS_SSQP + (size_t)6 * M * 64 * 4;
static_assert(LW_SIZE % 256 == 0 && WS_XN % 256 == 0 && WS_HID % 256 == 0 && WS_MIXO % 256 == 0 && WS_YPRE % 256 == 0, "alignment");
constexpr int RING_BYTES = 131072, LDSCTL_OFF = RING_BYTES, MISC_OFF = LDSCTL_OFF + 320, QKX_OFF = LDSCTL_OFF + 9216, LDS_BYTES = 148480;

struct Args { const float* in[26]; float* out; unsigned char* ws; int ph_lo, ph_hi; };
enum { I_X = 0, I_NORMW, I_FFNIN, I_FFNOUT, I_MIXIN, I_LRE, I_LIM, I_LOGDT, I_BRE, I_BIM, I_CRE, I_CIM, I_SSMD, I_GLUW, I_GLUB, I_QG, I_KG, I_LQ1, I_LK1, I_LQ2, I_LK2, I_SUBG, I_WBS, I_WBR, I_WBD, I_WOUT };

__device__ __forceinline__ float wave_sum(float v) {
#pragma unroll
    for (int o = 1; o < 64; o <<= 1) v += __shfl_xor(v, o);
    return v;
}
typedef __attribute__((address_space(3))) unsigned char lds_u8;

__device__ __forceinline__ void transpose_item(const float* W, int N, bf16* WT, int ldk, int kofs, int mode, const float* kscale, LAS float* scr, int item, int lane) {
    const int nblk = N / 32, kb = item / nblk, nb = item % nblk, k0 = 64 * kb, n0 = 32 * nb;
    int r0 = n0;
    if (mode == 1) { const int half = n0 >= FF ? 1 : 0, j = n0 - half * FF; r0 = (j >> 7) * 256 + half * 128 + (j & 127); }
    float wv[32];
#pragma unroll
    for (int i = 0; i < 32; ++i) wv[i] = __builtin_nontemporal_load(W + (size_t)(k0 + 2 * i + (lane >> 5)) * N + n0 + (lane & 31));
#pragma unroll
    for (int i = 0; i < 32; ++i) scr[(2 * i + (lane >> 5)) * 33 + (lane & 31)] = wv[i];
    LDS_WAIT(); asm volatile("" ::: "memory");
    const int c = lane & 7;
    f32x4 g0 = {1.f, 1.f, 1.f, 1.f}, g1 = g0;
    if (kscale) { g0 = *(const f32x4*)(kscale + k0 + 8 * c); g1 = *(const f32x4*)(kscale + k0 + 8 * c + 4); }
#pragma unroll
    for (int j = 0; j < 4; ++j) { const int n = (lane >> 3) + 8 * j; const LAS float* s = scr + (8 * c) * 33 + n;
        v4u o; o.x = pk2(s[0 * 33] * g0[0], s[1 * 33] * g0[1]); o.y = pk2(s[2 * 33] * g0[2], s[3 * 33] * g0[3]); o.z = pk2(s[4 * 33] * g1[0], s[5 * 33] * g1[1]); o.w = pk2(s[6 * 33] * g1[2], s[7 * 33] * g1[3]);
        const int slot = r0 + 16 * ((n >> 2) & 1) + 4 * (n >> 3) + (n & 3), kc = kofs + k0 + 8 * c;
        *(GAS v4u*)((GAS unsigned char*)WT + pg8::sub_off((size_t)slot, kc, ldk)) = o; }
    LDS_WAIT(); asm volatile("" ::: "memory");
}
__device__ __forceinline__ void conv_matrix(const float* W, int K, int N, bf16* WT, int ldk, int kofs, int mode, const float* kscale, LAS float* scr, int gw, int NGW, int lane, int part = 0) {
    const int nitems = (K / 64) * (N / 32), cut = nitems / 4;
    const int i0 = part == 2 ? cut : 0, i1 = part == 1 ? cut : nitems;
    for (int it = i0 + gw; it < i1; it += NGW) transpose_item(W, N, WT, ldk, kofs, mode, kscale, scr, it, lane);
}
constexpr int CVN_GLU = 16 * 32, CVN_BS = 16 * (D / 32), CVN_BR = 24 * (D / 32), CVN_OUT = (D / 64) * (D / 32), CVN_FI = (D / 64) * (2 * FF / 32), CVN_FO = (FF / 64) * (D / 32);
constexpr int CVN_MID = CVN_GLU + CVN_BS + 2 * CVN_BR + CVN_OUT + CVN_FI;
constexpr int CV_TOTAL = NLAYER * CVN_MID + (NLAYER - 1) * 2 * CVN_FO;
__device__ __forceinline__ void conv_stream_item(const Args& a, int it, LAS float* scr, int lane) {
    const float* W = nullptr; int N = 0; bf16* WT = nullptr; int ldk = 0, kofs = 0, mode = 0; const float* ks = nullptr; bool found = false;
#define CV_SEG(n_, W_, N_, WT_, ldk_, kofs_, mode_, ks_) if (!found) { if (it < (n_)) { W = (W_); N = (N_); WT = (bf16*)(WT_); ldk = (ldk_); kofs = (kofs_); mode = (mode_); ks = (ks_); found = true; } else it -= (n_); }
    for (int l = 0; l < NLAYER; ++l) { unsigned char* wl = a.ws + WS_W + (size_t)l * LW_SIZE;
        if (l > 0) CV_SEG(CVN_FO, a.in[I_FFNOUT] + (size_t)(l * 2 + 0) * FF * D, D, wl + LW_FO0, FF, 0, 0, nullptr)
        CV_SEG(CVN_GLU, a.in[I_GLUW] + (size_t)l * 1024 * 1024, 1024, wl + LW_GLU, 1024, 0, 0, nullptr)
        CV_SEG(CVN_BS, a.in[I_WBS] + (size_t)l * 1024 * D, D, wl + LW_BR, D, 0, 0, nullptr)
        CV_SEG(CVN_BR, a.in[I_WBR] + (size_t)l * 1536 * D, D, wl + LW_BR, D, 1024, 0, nullptr)
        CV_SEG(CVN_BR, a.in[I_WBD] + (size_t)l * 1536 * D, D, wl + LW_BR, D, 2560, 0, nullptr)
        CV_SEG(CVN_OUT, a.in[I_WOUT] + (size_t)l * D * D, D, wl + LW_OUT, D, 0, 0, nullptr)
        CV_SEG(CVN_FI, a.in[I_FFNIN] + (size_t)(l * 2 + 1) * D * 2 * FF, 2 * FF, wl + LW_FI1, D, 0, 1, a.in[I_NORMW] + (size_t)(l * 3 + 2) * D)
        if (l + 1 < NLAYER) CV_SEG(CVN_FO, a.in[I_FFNOUT] + (size_t)(l * 2 + 1) * FF * D, D, wl + LW_FO1, FF, 0, 0, nullptr)
    }
#undef CV_SEG
    if (found) transpose_item(W, N, WT, ldk, kofs, mode, ks, scr, it, lane);
}
constexpr int CVR_P0A_LO = 0, CVR_P0A_HI = CVN_GLU + CVN_BS + 2 * CVN_BR;
constexpr int CVR_T0_LO = CVR_P0A_HI, CVR_T0_HI = CVN_MID + CVN_FO;
constexpr int CVR_P0B_LO = CVR_T0_HI, CVR_P0B_HI = CVR_T0_HI + CVN_FO + CVN_GLU + CVN_BS + 2 * CVN_BR + CVN_OUT;
constexpr int CVR_T1_LO = CVR_P0B_HI, CVR_T1_HI = CV_TOTAL;
static_assert(NLAYER == 2 && CVR_T1_HI - CVR_T1_LO == CVN_FI, "conversion ranges are laid out for two layers");
__device__ __forceinline__ void conv_range(const Args& a, int lo, int hi, LAS float* scr, int gw, int NGW, int lane) { for (int it = lo + gw; it < hi; it += NGW) conv_stream_item(a, it, scr, lane); }
__device__ __forceinline__ void conv_phase(const Args& a, lds_u8* lds, int sel, int l0, int gw, int NGW, int lane, int wave) {
    LAS float* scr = (LAS float*)(lds + wave * 16384);
    for (int l = (sel == 0 ? 0 : l0); l < (sel == 0 ? NLAYER : l0 + 1); ++l) {
        unsigned char* wl = a.ws + WS_W + (size_t)l * LW_SIZE;
        const bool last = (l + 1 == NLAYER);
        if (sel == 0 && l == 0) conv_matrix(a.in[I_FFNIN] + (size_t)(l * 2 + 0) * D * 2 * FF, D, 2 * FF, (bf16*)(wl + LW_FI0), D, 0, 1, a.in[I_NORMW] + (size_t)(l * 3 + 0) * D, scr, gw, NGW, lane);
        if (sel == 0 && l == 0) { conv_matrix(a.in[I_FFNOUT] + (size_t)(l * 2 + 0) * FF * D, FF, D, (bf16*)(wl + LW_FO0), FF, 0, 0, nullptr, scr, gw, NGW, lane);
            conv_range(a, CVR_P0A_LO, CVR_P0A_HI, scr, gw, NGW, lane); conv_range(a, CVR_P0B_LO, CVR_P0B_HI, scr, gw, NGW, lane);
            if (gridDim.x != 256) { conv_range(a, CVR_T0_LO, CVR_T0_HI, scr, gw, NGW, lane); conv_range(a, CVR_T1_LO, CVR_T1_HI, scr, gw, NGW, lane); } }
        if (sel == 1) conv_matrix(a.in[I_MIXIN] + (size_t)l * D * NIN, D, NIN, (bf16*)(wl + LW_MIX), D, 0, 0, a.in[I_NORMW] + (size_t)(l * 3 + 1) * D, scr, gw, NGW, lane);
        if (sel == 2 && !last) {
            unsigned char* wn = wl + LW_SIZE;
            conv_matrix(a.in[I_FFNIN] + (size_t)((l + 1) * 2 + 0) * D * 2 * FF, D, 2 * FF, (bf16*)(wn + LW_FI0), D, 0, 1, a.in[I_NORMW] + (size_t)((l + 1) * 3 + 0) * D, scr, gw, NGW, lane); }
        if (sel == 2 && last) conv_matrix(a.in[I_FFNOUT] + (size_t)(l * 2 + 1) * FF * D, FF, D, (bf16*)(wl + LW_FO1), FF, 0, 0, nullptr, scr, gw, NGW, lane);
    }
}
__device__ __forceinline__ void cast_phase(const float* x, bf16* h16, float* ssq, int gw, int NGW, int lane) {
    for (int m = gw; m < M; m += NGW) {
        const GAS f32x4* xr = (const GAS f32x4*)(x + (size_t)m * D) + lane;
        float s = 0.f;
#pragma unroll
        for (int j = 0; j < 16; ++j) { const f32x4 v = xr[64 * j]; s += (v.x * v.x + v.y * v.y) + (v.z * v.z + v.w * v.w); v2u w; w.x = pk2(v.x, v.y); w.y = pk2(v.z, v.w);
            *(GAS v2u*)((GAS unsigned char*)h16 + pg8::sub_off((size_t)m, 4 * lane + 256 * j, D)) = w; }
        s = wave_sum(s);
        ssq[(size_t)m * 64 + lane] = lane == 0 ? s : 0.f;
    }
}
__device__ __forceinline__ float gelu_tanh(float x) { const float z = 0.7978845608028654f * (x + 0.044715f * x * x * x); return x * sigm(2.0f * z); }
#define MFMA16(A, B, C) __builtin_amdgcn_mfma_f32_16x16x32_bf16((A), (B), (C), 0, 0, 0)
__device__ __forceinline__ void ssm_phase(const Args& a, int layer, lds_u8* lds, int lane, int wave, int first, int stride) {
    const bf16* mixo = (const bf16*)(a.ws + WS_MIXO); bf16* ypre = (bf16*)(a.ws + WS_YPRE);
    lds_u8* wb = lds + wave * 13312;
    LAS float* BU = (LAS float*)wb;
    lds_u8* Xs = wb + 8192;
    lds_u8* Ub = wb + 12288;
    lds_u8* Yb = wb + 12800;
    LAS float* sS = (LAS float*)(lds + 106496);
    lds_u8* Bt = lds + 110592;
    lds_u8* Ct = lds + 114688;
    const int l15 = lane & 15, kq = lane >> 4;
    for (int item = first; item < NB * 64; item += stride) {
        const int b = item >> 6, g = item & 63, lg = layer * 64 + g, p = lane;
        const float dt = expf(a.in[I_LOGDT][lg]);
        const float lr = a.in[I_LRE][lg * 64 + p], li = a.in[I_LIM][lg * 64 + p];
        const float mag = expf(lr * dt); float sn, cs; sincosf(li * dt, &sn, &cs);
        const float ar = mag * cs, ai = mag * sn;
        __syncthreads();
        if (wave == 0) {
            const float den = lr * lr + li * li, nr = ar - 1.0f, ni = ai;
            const float cfr = (nr * lr + ni * li) / den, cfi = (ni * lr - nr * li) / den;
            const float* br = a.in[I_BRE] + ((size_t)lg * 64 + p) * 16; const float* bi = a.in[I_BIM] + ((size_t)lg * 64 + p) * 16;
            unsigned wre[8], wim[8];
#pragma unroll
            for (int i = 0; i < 8; ++i) { const float r0 = cfr * br[2 * i] - cfi * bi[2 * i], r1 = cfr * br[2 * i + 1] - cfi * bi[2 * i + 1], i0 = cfr * bi[2 * i] + cfi * br[2 * i], i1 = cfr * bi[2 * i + 1] + cfi * br[2 * i + 1];
                wre[i] = pk2(r0, r1); wim[i] = pk2(i0, i1); }
            *(LAS v4u*)(Bt + (2 * p) * 32) = (v4u){wre[0], wre[1], wre[2], wre[3]}; *(LAS v4u*)(Bt + (2 * p) * 32 + 16) = (v4u){wre[4], wre[5], wre[6], wre[7]};
            *(LAS v4u*)(Bt + (2 * p + 1) * 32) = (v4u){wim[0], wim[1], wim[2], wim[3]}; *(LAS v4u*)(Bt + (2 * p + 1) * 32 + 16) = (v4u){wim[4], wim[5], wim[6], wim[7]};
#pragma unroll
            for (int i = 0; i < 16; ++i) { const float cr_ = a.in[I_CRE][((size_t)lg * 16 + i) * 64 + p], ci_ = a.in[I_CIM][((size_t)lg * 16 + i) * 64 + p];
                *(LAS unsigned*)(Ct + i * 256 + p * 4) = pk2(cr_, -ci_); }
        }
        float pr = ar, pi = ai;
#pragma unroll
        for (int k = 0; k < 9; ++k) { const float n1 = pr * pr - pi * pi, n2 = 2.0f * pr * pi; pr = n1; pi = n2; }
        __syncthreads();
        bf16x8 bfrag[8], cfrag[4];
#pragma unroll
        for (int nb = 0; nb < 8; ++nb) { bfrag[nb] = (bf16x8){0, 0, 0, 0, 0, 0, 0, 0}; if (kq < 2) bfrag[nb] = *(const LAS bf16x8*)(Bt + (16 * nb + l15) * 32 + kq * 16); }
#pragma unroll
        for (int ks = 0; ks < 4; ++ks) cfrag[ks] = *(const LAS bf16x8*)(Ct + l15 * 256 + (32 * ks + 8 * kq) * 2);
        const float dsk = a.in[I_SSMD][lg * 16 + l15];
        const size_t rowbase = (size_t)b * SEQ + wave * 512;
        const bf16* up = mixo + (rowbase + l15) * NIN + C_U + g * 16 + (kq & 1) * 8;
        float xr = 0.f, xi = 0.f;
        for (int pass = 0; pass < 2; ++pass) {
            bf16x8 ufr = *(const bf16x8*)up;
            for (int ch = 0; ch < 32; ++ch) {
                bf16x8 ua = ufr; if (kq >= 2) ua = (bf16x8){0, 0, 0, 0, 0, 0, 0, 0};
                if (ch + 1 < 32) ufr = *(const bf16x8*)(up + (size_t)(ch + 1) * 16 * NIN);
                if (pass == 1 && kq < 2) *(LAS bf16x8*)(Ub + l15 * 32 + kq * 16) = ua;
#pragma unroll
                for (int nb = 0; nb < 8; ++nb) { f32x4 acc = {0.f, 0.f, 0.f, 0.f}; acc = MFMA16(ua, bfrag[nb], acc);
#pragma unroll
                    for (int r = 0; r < 4; ++r) BU[(4 * kq + r) * 128 + 16 * nb + l15] = acc[r]; }
#pragma unroll
                for (int t = 0; t < 16; ++t) { const f32x2v bu = *(const LAS f32x2v*)(BU + t * 128 + 2 * p);
                    const float n1 = ar * xr - ai * xi + bu.x, n2 = ar * xi + ai * xr + bu.y; xr = n1; xi = n2;
                    if (pass == 1) *(LAS unsigned*)(Xs + t * 256 + p * 4) = pk2(xr, xi); }
                if (pass == 1) {
                    f32x4 y = {0.f, 0.f, 0.f, 0.f};
#pragma unroll
                    for (int ks = 0; ks < 4; ++ks) { const bf16x8 xa = *(const LAS bf16x8*)(Xs + l15 * 256 + (32 * ks + 8 * kq) * 2); y = MFMA16(xa, cfrag[ks], y); }
#pragma unroll
                    for (int r = 0; r < 4; ++r) { const int t = 4 * kq + r; const float u = __uint_as_float((unsigned)(*(const LAS unsigned short*)(Ub + t * 32 + l15 * 2)) << 16);
                        *(LAS unsigned short*)(Yb + t * 32 + l15 * 2) = (unsigned short)(pk2(gelu_tanh(y[r] + dsk * u), 0.f) & 0xffffu); }
                    if (lane < 32) *(v4u*)((unsigned char*)ypre + pg8::sub_off(rowbase + ch * 16 + (lane >> 1), g * 16 + (lane & 1) * 8, 1024)) = *(const LAS v4u*)(Yb + (lane >> 1) * 32 + (lane & 1) * 16);
                }
            }
            if (pass == 0) {
                sS[(wave * 64 + lane) * 2] = xr; sS[(wave * 64 + lane) * 2 + 1] = xi;
                __syncthreads();
                float ir = 0.f, ii = 0.f;
                for (int v = 0; v < wave; ++v) { const float sr = sS[(v * 64 + lane) * 2], si = sS[(v * 64 + lane) * 2 + 1]; const float n1 = pr * ir - pi * ii + sr, n2 = pr * ii + pi * ir + si; ir = n1; ii = n2; }
                xr = ir; xi = ii;
            }
        }
    }
}
__device__ __forceinline__ void qknorm_phase(const Args& a, int layer, int gw, int NGW, int lane) {
    bf16* mixo = (bf16*)(a.ws + WS_MIXO);
    float gq[8], gk[8];
#pragma unroll
    for (int j = 0; j < 8; ++j) { gq[j] = a.in[I_QG][layer * 64 + (lane & 7) * 8 + j] * (0.125f * LOG2E); gk[j] = a.in[I_KG][layer * 64 + (lane & 7) * 8 + j]; }
    for (int m = gw; m < M; m += NGW) {
#pragma unroll
        for (int part = 0; part < 2; ++part)
#pragma unroll
            for (int it = 0; it < 3; ++it) {
                bf16* p = mixo + (size_t)m * NIN + (part ? C_DK : C_DQ) + it * 512 + lane * 8;
                const v4u w = *(const v4u*)p;
                float f[8] = {bflo(w.x), bfhi(w.x), bflo(w.y), bfhi(w.y), bflo(w.z), bfhi(w.z), bflo(w.w), bfhi(w.w)};
                float ss = 0.f;
#pragma unroll
                for (int j = 0; j < 8; ++j) ss += f[j] * f[j];
                ss += __shfl_xor(ss, 1); ss += __shfl_xor(ss, 2); ss += __shfl_xor(ss, 4);
                const float r = 1.0f / sqrtf(ss * (1.0f / 64.0f) + EPS);
#pragma unroll
                for (int j = 0; j < 8; ++j) f[j] *= r * (part ? gk[j] : gq[j]);
                *(v4u*)p = (v4u){pk2(f[0], f[1]), pk2(f[2], f[3]), pk2(f[4], f[5]), pk2(f[6], f[7])};
            }
    }
}
__device__ __forceinline__ int tr_lane_off(int lane, int rs) { const int i = lane & 15; return (4 * (lane >> 5) + (i >> 2)) * rs + (16 * ((lane >> 4) & 1) + 4 * (i & 3)) * 2; }
__device__ __forceinline__ bf16x8 tr_frag(const lds_u8* p, int rs8) {
    const v4i16_t lo = __builtin_amdgcn_ds_read_tr16_b64_v4i16((LAS v4i16_t*)p), hi = __builtin_amdgcn_ds_read_tr16_b64_v4i16((LAS v4i16_t*)(p + rs8));
    return (bf16x8){lo[0], lo[1], lo[2], lo[3], hi[0], hi[1], hi[2], hi[3]};
}
__device__ __forceinline__ bf16x8 pack8(float a0, float a1, float a2, float a3, float a4, float a5, float a6, float a7) {
    const v4u w = {pk2(a0, a1), pk2(a2, a3), pk2(a4, a5), pk2(a6, a7)}; return __builtin_bit_cast(bf16x8, w);
}
#define MFMA32(A, B, C) __builtin_amdgcn_mfma_f32_32x32x16_bf16((A), (B), (C), 0, 0, 0)
__device__ __forceinline__ f32x16 zero16() { f32x16 z; for (int i = 0; i < 16; ++i) z[i] = 0.f; return z; }

__device__ __forceinline__ void ret_state_phase(const Args& a, int layer, lds_u8* lds, int tid, int lane, int wave) {
    constexpr int RS = 320;
    const bf16* mixo = (const bf16*)(a.ws + WS_MIXO); bf16* prevT = (bf16*)(a.ws + WS_PREVT);
    lds_u8* Ks = lds; lds_u8* Vs = lds + 128 * RS; lds_u8* Ss = lds + 2 * 128 * RS;
    const int troff = tr_lane_off(lane, RS), l31 = lane & 31, hh = lane >> 5;
    const int dvb = wave >> 1, dkb0 = (wave & 1) * 2;
    for (int item = (int)gridDim.x - 1 - (int)blockIdx.x; item < NB * 6 * 2; item += gridDim.x) {
        const int dvh = item & 1, h = (item >> 1) % 6, b = item / 12;
        const float lg2 = log2f(1.0f - exp2f(-5.0f - (float)h)), cd = ex2(lg2 * 128.0f);
        f32x16 st0 = zero16(), st1 = zero16();
        v4u kreg0[4], vreg0[4], kreg1[4], vreg1[4];
#define RS_LOAD(KR, VR, n) do { _Pragma("unroll") for (int i_ = 0; i_ < 4; ++i_) { const int cid_ = tid + 512 * i_, row_ = cid_ >> 4, cc_ = cid_ & 15; const bf16* rp_ = mixo + ((size_t)b * SEQ + (n) * 128 + row_) * NIN; \
            KR[i_] = *(const v4u*)(rp_ + C_RK + h * 128 + cc_ * 8); VR[i_] = *(const v4u*)(rp_ + C_RV + h * 256 + dvh * 128 + cc_ * 8); } } while (0)
#define RS_PART_A(n) { \
            _Pragma("unroll") for (int rq = 0; rq < 4; ++rq) { \
                *(LAS v2u*)(Ss + (dvb * 32 + l31) * 272 + (dkb0 * 32 + 8 * rq + 4 * hh) * 2) = (v2u){pk2(st0[4 * rq], st0[4 * rq + 1]), pk2(st0[4 * rq + 2], st0[4 * rq + 3])}; \
                *(LAS v2u*)(Ss + (dvb * 32 + l31) * 272 + ((dkb0 + 1) * 32 + 8 * rq + 4 * hh) * 2) = (v2u){pk2(st1[4 * rq], st1[4 * rq + 1]), pk2(st1[4 * rq + 2], st1[4 * rq + 3])}; } \
            __syncthreads();                                     \
            { bf16* pt = prevT + ((size_t)((b * 6 + h) * 32 + (n)) * 256 + dvh * 128) * 128; \
              v4u sv_[4]; _Pragma("unroll") for (int i = 0; i < 4; ++i) { const int cid = tid + 512 * i, row = cid >> 4, cc = cid & 15; sv_[i] = *(const LAS v4u*)(Ss + row * 272 + cc * 16); } \
              _Pragma("unroll") for (int i = 0; i < 4; ++i) { const int cid = tid + 512 * i, row = cid >> 4, cc = cid & 15; *(v4u*)(pt + row * 128 + cc * 8) = sv_[i]; } } }
#define RS_PART_B(KR, VR, n) { \
            _Pragma("unroll") for (int i = 0; i < 4; ++i) { const int cid = tid + 512 * i, row = cid >> 4, cc = cid & 15; const float sc = ex2(lg2 * (float)(127 - row)) * 0.08838834764831845f; \
                const v4u k = KR[i]; \
                const v4u ks = {pk2(bflo(k.x) * sc, bfhi(k.x) * sc), pk2(bflo(k.y) * sc, bfhi(k.y) * sc), pk2(bflo(k.z) * sc, bfhi(k.z) * sc), pk2(bflo(k.w) * sc, bfhi(k.w) * sc)}; \
                *(LAS v4u*)(Ks + row * RS + cc * 16) = ks; *(LAS v4u*)(Vs + row * RS + cc * 16) = VR[i]; } \
            __syncthreads(); \
            if ((n) + 2 < 31) RS_LOAD(KR, VR, (n) + 2); \
            st0 *= cd; st1 *= cd; \
            { bf16x8 A = tr_frag(Vs + troff + dvb * 64, 8 * RS), B0 = tr_frag(Ks + troff + dkb0 * 64, 8 * RS), B1 = tr_frag(Ks + troff + (dkb0 + 1) * 64, 8 * RS); \
              _Pragma("unroll") for (int s = 0; s < 8; ++s) { \
                  bf16x8 An = A, B0n = B0, B1n = B1; \
                  if (s + 1 < 8) { An = tr_frag(Vs + troff + 16 * (s + 1) * RS + dvb * 64, 8 * RS); B0n = tr_frag(Ks + troff + 16 * (s + 1) * RS + dkb0 * 64, 8 * RS); B1n = tr_frag(Ks + troff + 16 * (s + 1) * RS + (dkb0 + 1) * 64, 8 * RS); } \
                  st0 = MFMA32(B0, A, st0); st1 = MFMA32(B1, A, st1); \
                  A = An; B0 = B0n; B1 = B1n; \
              } } }
        RS_LOAD(kreg0, vreg0, 0); RS_LOAD(kreg1, vreg1, 1);
        for (int n = 0; n < 32; n += 2) {
            RS_PART_A(n); RS_PART_B(kreg0, vreg0, n);
            RS_PART_A(n + 1); if (n == 30) break;
            RS_PART_B(kreg1, vreg1, n + 1);
        }
#undef RS_PART_A
#undef RS_PART_B
#undef RS_LOAD
        asm volatile("s_waitcnt vmcnt(0)" ::: "memory");
        __syncthreads();
        if (tid == 0) { __builtin_amdgcn_fence(__ATOMIC_RELEASE, "agent"); asm volatile("s_waitcnt vmcnt(0)" ::: "memory");
            (void)__hip_atomic_fetch_add((unsigned*)(a.ws + WS_CTL) + CW_RSF + 64 * layer, 1u, __ATOMIC_RELAXED, __HIP_MEMORY_SCOPE_AGENT); }
    }
}
__device__ __forceinline__ void ret_state_wait(const Args& a, int layer, int tid) {
    if (tid == 0) { unsigned* ctl = (unsigned*)(a.ws + WS_CTL); unsigned* bar = ctl + CW_BAR;
        XB_SPIN(xb_ld(ctl + CW_RSF + 64 * layer) < (unsigned)(NB * 6 * 2), bar);
        __builtin_amdgcn_fence(__ATOMIC_ACQUIRE, "agent"); asm volatile("s_waitcnt vmcnt(0)" ::: "memory"); }
    __syncthreads();
}
__device__ __forceinline__ void ret_out_phase(const Args& a, lds_u8* lds, int tid, int lane, int wave) {
    constexpr int RK = 272, RV = 576, RO = 528;
    const bf16* mixo = (const bf16*)(a.ws + WS_MIXO); const bf16* prevT = (const bf16*)(a.ws + WS_PREVT); bf16* ycat = (bf16*)(a.ws + WS_YCAT);
    lds_u8* Ks = lds; lds_u8* Vs = lds + 128 * RK; lds_u8* Ps = lds; lds_u8* Os = lds;
    LAS float* ssS = (LAS float*)(lds + 112640);
    const int qb = wave & 3, dvh = wave >> 2, l31 = lane & 31, hh = lane >> 5;
    const int troffV = tr_lane_off(lane, RV);
    for (int item = blockIdx.x; item < NB * 32 * 6; item += gridDim.x) {
        const int h = item % 6, n = (item / 6) & 31, b = item / 192;
        const float lg2 = log2f(1.0f - exp2f(-5.0f - (float)h));
        const size_t row0 = (size_t)b * SEQ + n * 128;
        __syncthreads();
#pragma unroll
        for (int i = 0; i < 4; ++i) { const int cid = tid + 512 * i, row = cid >> 4, cc = cid & 15; const float sc = ex2(-lg2 * (float)(row + 1)) * 0.08838834764831845f;
            const v4u k = *(const v4u*)(mixo + (row0 + row) * NIN + C_RK + h * 128 + cc * 8);
            const v4u ks = {pk2(bflo(k.x) * sc, bfhi(k.x) * sc), pk2(bflo(k.y) * sc, bfhi(k.y) * sc), pk2(bflo(k.z) * sc, bfhi(k.z) * sc), pk2(bflo(k.w) * sc, bfhi(k.w) * sc)};
            *(LAS v4u*)(Ks + row * RK + cc * 16) = ks; }
#pragma unroll 4
        for (int i = 0; i < 8; ++i) { const int cid = tid + 512 * i, row = cid >> 5, cc = cid & 31; *(LAS v4u*)(Vs + row * RV + cc * 16) = *(const v4u*)(mixo + (row0 + row) * NIN + C_RV + h * 256 + cc * 8); }
        bf16x8 qf[8];
        { const bf16* qp = mixo + (row0 + qb * 32 + l31) * NIN + C_RQ + h * 128 + 8 * hh;
#pragma unroll
          for (int s = 0; s < 8; ++s) qf[s] = *(const bf16x8*)(qp + 16 * s); }
        v4u pv[8];
        { const bf16* pt = prevT + (size_t)((b * 6 + h) * 32 + n) * 256 * 128;
#pragma unroll
          for (int i = 0; i < 8; ++i) { const int cid = tid + 512 * i, row = cid >> 4, cc = cid & 15; pv[i] = *(const v4u*)(pt + row * 128 + cc * 8); } }
        f32x16 o[4];
#pragma unroll
        for (int db = 0; db < 4; ++db) o[db] = zero16();
        __syncthreads();
#pragma unroll
        for (int kb = 0; kb < 4; ++kb) {
            if (kb <= qb) {
                f32x16 st = zero16();
#pragma unroll
                for (int s = 0; s < 8; ++s) { const bf16x8 A = *(const LAS bf16x8*)(Ks + (kb * 32 + l31) * RK + (16 * s + 8 * hh) * 2); st = MFMA32(A, qf[s], st); }
                if (kb == qb) {
#pragma unroll
                    for (int r = 0; r < 16; ++r) if ((r & 3) + 8 * (r >> 2) + 4 * hh > l31) st[r] = 0.f;
                }
                const bf16x8 p0 = pack8(st[0], st[1], st[2], st[3], st[4], st[5], st[6], st[7]), p1 = pack8(st[8], st[9], st[10], st[11], st[12], st[13], st[14], st[15]);
#pragma unroll
                for (int db = 0; db < 4; ++db) { const bf16x8 A0 = tr_frag(Vs + troffV + 32 * kb * RV + (dvh * 128 + db * 32) * 2, 8 * RV), A1 = tr_frag(Vs + troffV + (32 * kb + 16) * RV + (dvh * 128 + db * 32) * 2, 8 * RV);
                    o[db] = MFMA32(A0, p0, o[db]); o[db] = MFMA32(A1, p1, o[db]); }
            }
            __builtin_amdgcn_sched_barrier(0);
        }
        __syncthreads();
#pragma unroll
        for (int i = 0; i < 8; ++i) { const int cid = tid + 512 * i, row = cid >> 4, cc = cid & 15; *(LAS v4u*)(Ps + row * RK + cc * 16) = pv[i]; }
        v4u gv[8];
#pragma unroll
        for (int i = 0; i < 8; ++i) { const int cid = tid + 512 * i, row = cid >> 5, cc = cid & 31; gv[i] = *(const v4u*)(mixo + (row0 + row) * NIN + C_RG + h * 256 + cc * 8); }
        __syncthreads();
#pragma unroll
        for (int db = 0; db < 4; ++db) {
#pragma unroll
            for (int s = 0; s < 8; ++s) { const bf16x8 A = *(const LAS bf16x8*)(Ps + (dvh * 128 + db * 32 + l31) * RK + (16 * s + 8 * hh) * 2); o[db] = MFMA32(A, qf[s], o[db]); }
            __builtin_amdgcn_sched_barrier(0);
        }
        float ss = 0.f;
#pragma unroll
        for (int db = 0; db < 4; ++db)
#pragma unroll
            for (int r = 0; r < 16; ++r) ss += o[db][r] * o[db][r];
        ss += __shfl_xor(ss, 32);
        if (hh == 0) ssS[wave * 32 + l31] = ss;
        __syncthreads();
        const float rstd = 1.0f / sqrtf((ssS[wave * 32 + l31] + ssS[(wave ^ 4) * 32 + l31]) * (1.0f / 256.0f) + EPS * ex2(-2.0f * lg2 * (float)(qb * 32 + l31 + 1)));
#pragma unroll
        for (int db = 0; db < 4; ++db)
#pragma unroll
            for (int rq = 0; rq < 4; ++rq) { const int dv = dvh * 128 + db * 32 + 8 * rq + 4 * hh;
                const v2u w = {pk2(o[db][4 * rq] * rstd, o[db][4 * rq + 1] * rstd), pk2(o[db][4 * rq + 2] * rstd, o[db][4 * rq + 3] * rstd)};
                *(LAS v2u*)(Os + (qb * 32 + l31) * RO + dv * 2) = w; }
        __syncthreads();
#pragma unroll
        for (int i = 0; i < 8; ++i) { const int cid = tid + 512 * i, row = cid >> 5, cc = cid & 31;
            const v4u ov = *(const LAS v4u*)(Os + row * RO + cc * 16);
            float g[8] = {bflo(gv[i].x), bfhi(gv[i].x), bflo(gv[i].y), bfhi(gv[i].y), bflo(gv[i].z), bfhi(gv[i].z), bflo(gv[i].w), bfhi(gv[i].w)};
            float ov8[8] = {bflo(ov.x), bfhi(ov.x), bflo(ov.y), bfhi(ov.y), bflo(ov.z), bfhi(ov.z), bflo(ov.w), bfhi(ov.w)};
#pragma unroll
            for (int j = 0; j < 8; ++j) ov8[j] *= g[j] * sigm(g[j]);
            *(v4u*)((unsigned char*)ycat + pg8::sub_off(row0 + row, 1024 + h * 256 + cc * 8, D)) = (v4u){pk2(ov8[0], ov8[1]), pk2(ov8[2], ov8[3]), pk2(ov8[4], ov8[5]), pk2(ov8[6], ov8[7])}; }
    }
}
__device__ __forceinline__ void glds16(const void* gsrc, unsigned lds_dst) { unsigned keep;
    asm volatile("s_mov_b32 %0, m0\n\ts_mov_b32 m0, %2\n\ts_nop 0\n\tglobal_load_lds_dwordx4 %1, off\n\ts_mov_b32 m0, %0" : "=&s"(keep) : "v"(gsrc), "s"(lds_dst) : "memory"); }
__device__ __forceinline__ void attn_phase(const Args& a, int layer, lds_u8* lds, int tid, int lane, int wave) {
    constexpr int RK = 144, RV = 320, STG = 2 * 64 * RK + 64 * RV;
    const bf16* mixo = (const bf16*)(a.ws + WS_MIXO); bf16* ycat = (bf16*)(a.ws + WS_YCAT);
    const int l31 = lane & 31, hh = lane >> 5, map = wave >> 2, qs = wave & 3;
    const int troffV = tr_lane_off(lane, RV);
    const float lambda_init = 0.8f - 0.6f * expf(-0.3f * (float)layer);
    float lam;
    { const float s1 = wave_sum(a.in[I_LQ1][layer * 64 + lane] * a.in[I_LK1][layer * 64 + lane]), s2 = wave_sum(a.in[I_LQ2][layer * 64 + lane] * a.in[I_LK2][layer * 64 + lane]);
      lam = expf(s1) - expf(s2) + lambda_init; lam = __uint_as_float(__builtin_amdgcn_readfirstlane(__float_as_uint(lam))); }
    float thr, s2max;
    { float mq = fabsf(a.in[I_QG][layer * 64 + lane]), mk = fabsf(a.in[I_KG][layer * 64 + lane]);
#pragma unroll
      for (int o = 1; o < 64; o <<= 1) { mq = fmaxf(mq, __shfl_xor(mq, o)); mk = fmaxf(mk, __shfl_xor(mk, o)); }
      s2max = (8.0f * LOG2E * mq * mk) * 1.01f; s2max = __uint_as_float(__builtin_amdgcn_readfirstlane(__float_as_uint(s2max))); thr = 152.0f + 2.0f * s2max; }
    const int G = gridDim.x, xch = blockIdx.x & 7;
    const unsigned hpack = (xch & 1) ? 0x1349ABu : 0x025678u;
    unsigned* qctr = (unsigned*)(a.ws + WS_CTL) + CW_ATTQ + (layer * 8 + xch) * 64;
    volatile LAS unsigned* tick = (volatile LAS unsigned*)(lds + MISC_OFF) + 12;
    for (int rnd = 0;; ++rnd) {
        int b, hd, qb;
        if (G == 256) {
            if (tid == 0) *tick = __hip_atomic_fetch_add(qctr, 1u, __ATOMIC_RELAXED, __HIP_MEMORY_SCOPE_AGENT);
            __syncthreads();
            const int u = __builtin_amdgcn_readfirstlane((int)*tick); if (u >= 192) break;
            b = xch >> 1; hd = (hpack >> (4 * (u >> 5))) & 15; qb = 31 - (u & 31); }
        else { const int u = rnd * G + blockIdx.x; if (u >= NB * 12 * 32) break; qb = 31 - u / 48; b = (u % 48) / 12; hd = u % 12; }
        const float slope2 = exp2f(-8.0f * (float)(hd + 1) / 12.0f) * LOG2E;
        const size_t row0 = (size_t)b * SEQ;
        const int qw = qb * 128 + qs * 32;
        bf16x8 qf[4];
        { const bf16* qp = mixo + (row0 + qw + l31) * NIN + C_DQ + hd * 128 + map * 64 + 8 * hh;
#pragma unroll
          for (int s = 0; s < 4; ++s) qf[s] = *(const bf16x8*)(qp + 16 * s); }
        f32x16 o[4];
#pragma unroll
        for (int db = 0; db < 4; ++db) o[db] = zero16();
        float lrun = 0.f;
        const int kt1 = 2 * qb + 1; int kt0; { const int W = (int)fminf(thr / slope2, 100000.0f) + 1, x = 128 * qb - W - 63; kt0 = x <= 0 ? 0 : (x + 63) >> 6; }
        const int ntile = kt1 - kt0 + 1;
        constexpr int STG3 = 40 * 1024;
        unsigned goff[5];
#pragma unroll
        for (int i = 0; i < 5; ++i) { int c = (wave + 8 * i) * 64 + lane; asm volatile("" : "+v"(c)); int row, colb;
            if (c < 576) { row = c / 9; const int cc = c - row * 9; colb = (C_DK + hd * 128) * 2 + (cc > 7 ? 7 : cc) * 16; }
            else if (c < 1152) { const int c2 = c - 576; row = c2 / 9; const int cc = c2 - row * 9; colb = (C_DK + hd * 128 + 64) * 2 + (cc > 7 ? 7 : cc) * 16; }
            else if (c < 2432) { const int c3 = c - 1152; row = c3 / 20; const int cc = c3 - row * 20; colb = (C_DV + hd * 128) * 2 + (cc > 15 ? 15 : cc) * 16; }
            else { row = 0; colb = (C_DK + hd * 128) * 2; }
            goff[i] = (unsigned)row * (unsigned)(NIN * 2) + (unsigned)colb; }
        const char* tile0 = (const char*)(mixo + (row0 + (size_t)kt0 * 64) * NIN);
        const unsigned lds_base = (unsigned)(size_t)lds;
        bf16x8 pf[4];
#define ATT_DMA(it, stg) do { const char* tb_ = tile0 + (size_t)(it) * (64 * NIN * 2); _Pragma("unroll") for (int i_ = 0; i_ < 5; ++i_) \
            glds16(tb_ + goff[i_], lds_base + (unsigned)((stg) * STG3 + (wave + 8 * i_) * 1024)); } while (0)
#define ATT_TILE(it, sbase) do { const int kt_ = kt0 + (it); { const lds_u8* Kb = (sbase) + map * 64 * RK; f32x16 st[2]; \
            const float b0 = slope2 * (float)(kt_ * 64 + 4 * hh - (qw + l31)) - s2max; \
            _Pragma("unroll") for (int kb2 = 0; kb2 < 2; ++kb2) _Pragma("unroll") for (int r = 0; r < 16; ++r) st[kb2][r] = b0 + slope2 * (float)(kb2 * 32 + (r & 3) + 8 * (r >> 2)); \
            bf16x8 kf_[8];   \
            _Pragma("unroll") for (int i_ = 0; i_ < 8; ++i_) kf_[i_] = *(const LAS bf16x8*)(Kb + ((i_ >> 2) * 32 + l31) * RK + (16 * (i_ & 3) + 8 * hh) * 2); \
            _Pragma("unroll") for (int s = 0; s < 4; ++s) { st[0] = MFMA32(kf_[s], qf[s], st[0]); st[1] = MFMA32(kf_[4 + s], qf[s], st[1]); } \
            ATT_H2A(sbase); \
            if (kt_ * 64 + 63 > qw) { const int qrel = qw + l31 - kt_ * 64 - 4 * hh; \
                _Pragma("unroll") for (int kb2 = 0; kb2 < 2; ++kb2) _Pragma("unroll") for (int r = 0; r < 16; ++r) if (kb2 * 32 + (r & 3) + 8 * (r >> 2) > qrel) st[kb2][r] = -1e30f; } \
            float rs = 0.f; \
            _Pragma("unroll") for (int kb2 = 0; kb2 < 2; ++kb2) _Pragma("unroll") for (int r = 0; r < 16; ++r) { const float p = ex2(st[kb2][r]); st[kb2][r] = p; rs += p; } \
            lrun += rs; \
            _Pragma("unroll") for (int ks = 0; ks < 4; ++ks) { const int kb2 = ks >> 1, r0 = (ks & 1) * 8; pf[ks] = pack8(st[kb2][r0], st[kb2][r0 + 1], st[kb2][r0 + 2], st[kb2][r0 + 3], st[kb2][r0 + 4], st[kb2][r0 + 5], st[kb2][r0 + 6], st[kb2][r0 + 7]); } \
            ATT_H2B(); } } while (0)
#define ATT_VF(i) tr_frag(Vb_ + troffV + 16 * ((i) >> 2) * RV + ((i) & 3) * 64, 8 * RV)
#define ATT_H2A(sbase) const lds_u8* Vb_ = (sbase) + 2 * 64 * RK; bf16x8 vf0_ = ATT_VF(0), vf1_ = ATT_VF(1), vf2_ = ATT_VF(2), vf3_ = ATT_VF(3)
#define ATT_H2B() do { _Pragma("unroll") for (int i_ = 0; i_ < 16; i_ += 4) { \
                o[0] = MFMA32(vf0_, pf[i_ >> 2], o[0]); if (i_ + 4 < 16) vf0_ = ATT_VF(i_ + 4); \
                o[1] = MFMA32(vf1_, pf[i_ >> 2], o[1]); if (i_ + 5 < 16) vf1_ = ATT_VF(i_ + 5); \
                o[2] = MFMA32(vf2_, pf[i_ >> 2], o[2]); if (i_ + 6 < 16) vf2_ = ATT_VF(i_ + 6); \
                o[3] = MFMA32(vf3_, pf[i_ >> 2], o[3]); if (i_ + 7 < 16) vf3_ = ATT_VF(i_ + 7); } } while (0)
        asm volatile("" :: "v"(qf[0]), "v"(qf[1]), "v"(qf[2]), "v"(qf[3]));
        __syncthreads();
        ATT_DMA(0, 0);
        if (ntile > 1) ATT_DMA(1, 1);
        int scur = 0;
        for (int it = 0; it < ntile; ++it) {
            if (it + 1 < ntile) asm volatile("s_waitcnt vmcnt(5)" ::: "memory"); else asm volatile("s_waitcnt vmcnt(0)" ::: "memory");
            __builtin_amdgcn_s_barrier(); asm volatile("" ::: "memory");
            const int snext2 = scur == 0 ? 2 : scur - 1;
            if (it + 2 < ntile) ATT_DMA(it + 2, snext2);
            if ((kt0 + it) * 64 <= qw + 31) { const lds_u8* sb = lds + scur * STG3; ATT_TILE(it, sb); }
            scur = scur == 2 ? 0 : scur + 1;
        }
        asm volatile("s_waitcnt vmcnt(0)" ::: "memory");
        __syncthreads();
#undef ATT_DMA
#undef ATT_TILE
#undef ATT_H2A
#undef ATT_H2B
#undef ATT_VF
        lrun += __shfl_xor(lrun, 32);
        const float inv = 1.0f / lrun;
        LAS f32x4* Xs = (LAS f32x4*)lds;
        if (map == 1) {
#pragma unroll
            for (int db = 0; db < 4; ++db)
#pragma unroll
                for (int rq = 0; rq < 4; ++rq) Xs[(qs * 16 + db * 4 + rq) * 64 + lane] = (f32x4){o[db][4 * rq] * inv, o[db][4 * rq + 1] * inv, o[db][4 * rq + 2] * inv, o[db][4 * rq + 3] * inv};
        }
        __syncthreads();
        if (map == 0) {
            float ss = 0.f;
#pragma unroll
            for (int db = 0; db < 4; ++db)
#pragma unroll
                for (int rq = 0; rq < 4; ++rq) { const f32x4 x2 = Xs[(qs * 16 + db * 4 + rq) * 64 + lane];
#pragma unroll
                    for (int j = 0; j < 4; ++j) { const float d = o[db][4 * rq + j] * inv - lam * x2[j]; o[db][4 * rq + j] = d; ss += d * d; } }
            ss += __shfl_xor(ss, 32);
            const float rstd = (1.0f - lambda_init) / sqrtf(ss * (1.0f / 128.0f) + EPS);
            lds_u8* Os = lds + 65536 + qs * (32 * 272);
#pragma unroll
            for (int db = 0; db < 4; ++db)
#pragma unroll
                for (int rq = 0; rq < 4; ++rq) { const int dv = db * 32 + 8 * rq + 4 * hh; const f32x4 sg = *(const f32x4*)(a.in[I_SUBG] + layer * 128 + dv);
                    const v2u w = {pk2(o[db][4 * rq] * rstd * sg[0], o[db][4 * rq + 1] * rstd * sg[1]), pk2(o[db][4 * rq + 2] * rstd * sg[2], o[db][4 * rq + 3] * rstd * sg[3])};
                    *(LAS v2u*)(Os + l31 * 272 + dv * 2) = w; }
            asm volatile("" ::: "memory");
#pragma unroll
            for (int i = 0; i < 8; ++i) { const int cid = lane + 64 * i, row = cid >> 4, cc = cid & 15;
                *(v4u*)((unsigned char*)ycat + pg8::sub_off(row0 + qw + row, 2560 + hd * 128 + cc * 8, D)) = *(const LAS v4u*)(Os + row * 272 + cc * 16); }
        }
    }
}
__device__ __forceinline__ void stagger_start(int bx, unsigned step_ticks  ) {
    const unsigned long long t0 = __builtin_amdgcn_s_memrealtime(); const unsigned long long wait = (unsigned long long)(((unsigned)bx >> 3) & 3u) * step_ticks;
    while (__builtin_amdgcn_s_memrealtime() - t0 < wait) __builtin_amdgcn_s_sleep(8);
}
constexpr int N_PHASES = 1 + 9 * NLAYER;
#ifndef MK_ONE_LAUNCH
#define MK_ONE_LAUNCH 1
#endif
__global__ void __launch_bounds__(NWAVES * 64, 2) fwd_kernel(Args args) {
    extern __shared__ __attribute__((aligned(16))) unsigned char lds_raw[];
    lds_u8* lds = (lds_u8*)lds_raw;
    volatile LAS unsigned* MISC = (volatile LAS unsigned*)(lds + MISC_OFF);
    const int tid0 = threadIdx.x;
    const int wave_s = __builtin_amdgcn_readfirstlane(tid0 >> 6);
#define MK_TID(var) int var; asm volatile("v_mbcnt_lo_u32_b32 %0, -1, 0\n\tv_mbcnt_hi_u32_b32 %0, -1, %0" : "=v"(var)); var += wave_s * 64
    const int G = gridDim.x, bx = blockIdx.x;
    const int vcu = (G % 8 == 0) ? (bx % 8) * (G / 8) + bx / 8 : bx;
    const int NGW = G * NWAVES;
#if defined(PROBE_ZERO_LDS)
    for (int u = tid0; u < LDSCTL_OFF / 4; u += NWAVES * 64) ((LAS unsigned*)lds)[u] = 0u;
#endif
    for (int u = tid0; u < (LDS_BYTES - LDSCTL_OFF) / 4; u += NWAVES * 64) ((LAS unsigned*)(lds + LDSCTL_OFF))[u] = 0u;
    __syncthreads();
    unsigned* ctl = (unsigned*)(args.ws + WS_CTL);
    XcdBarrier bar; bar.bar = ctl + CW_BAR; bar.x = 0; bar.st = nullptr;
    const int lo = args.ph_lo, hi = args.ph_hi;
    if (hi - lo > 1) bar = xcd_barrier_post(ctl + CW_BAR, MISC + 8);
#if defined(PROBE_CLK)
    if (blockIdx.x == 0 && tid0 == 0) __hip_atomic_store((unsigned long long*)(args.ws + WS_CTL + 524288) + 100, (unsigned long long)__builtin_amdgcn_s_memtime(), __ATOMIC_RELAXED, __HIP_MEMORY_SCOPE_AGENT);
#endif
#if defined(PROBE_CLK)
    if (blockIdx.x == 0 && tid0 == 0) __hip_atomic_store((unsigned long long*)(args.ws + WS_CTL + 524288) + 100, (unsigned long long)__builtin_amdgcn_s_memtime(), __ATOMIC_RELAXED, __HIP_MEMORY_SCOPE_AGENT);
#endif
#ifndef PROBE_DUP
#define PROBE_DUP 0
#endif
#define DUPN(j) ((((PROBE_DUP) >> (j)) & 1) ? 2 : 1)
#if defined(PROBE_AMP)
#define STAMP(slot) do { { __syncthreads(); if (wave_s == 0) { MK_TID(ts_); if (ts_ == 0) __hip_atomic_store((unsigned long long*)(args.ws + WS_CTL + 524288) + bx * 64 + (slot), (unsigned long long)__builtin_amdgcn_s_memrealtime(), __ATOMIC_RELAXED, __HIP_MEMORY_SCOPE_AGENT); } } } while (0)
#else
#define STAMP(slot) do { } while (0)
#endif
#ifndef PG8_SP2
#define PG8_SP2 true
#endif
#ifndef STAG_RESID
#define STAG_RESID 200u
#endif
#ifndef WGM_FFNOUT
#define WGM_FFNOUT 2
#endif
#ifndef WGM_SQ
#define WGM_SQ 4
#endif
#ifndef WGM_WIDE
#define WGM_WIDE 8
#endif
#ifndef PROBE_NULL
#define PROBE_NULL 0
#endif
#ifndef PH_MASK
#define PH_MASK 0xffff
#endif
#define IN(k) (lo <= (k) && (k) < hi)
#define HAS(j) (((PH_MASK) >> (j)) & 1)
#define SEAM(k) do { if (IN(k) && IN((k) + 1)) { XcdBarrier b2_ = bar; asm volatile("" : "+s"(b2_.bar), "+s"(b2_.x));     \
        xcd_barrier(b2_); } } while (0)
    unsigned char* ws = args.ws;
    bf16* XN = (bf16*)(ws + WS_XN); bf16* HID = (bf16*)(ws + WS_HID); bf16* MIXO = (bf16*)(ws + WS_MIXO); bf16* YPRE = (bf16*)(ws + WS_YPRE); bf16* YCAT = (bf16*)(ws + WS_YCAT); bf16* MERGED = (bf16*)(ws + WS_MERGED);

    float* SSQ = (float*)(ws + WS_SSQP);
    static_assert(M / 256 == 64 && pg8::WGM == 8 && pg8::NXCD == 8, "row_scales_phase: a workgroup's units stay inside 8 row panels only for 64 panels / 8 XCD chunks / 8-panel groups");
    const int PM0 = 8 * (bx % 8);
    LAS float* RSL = (LAS float*)(lds + LDSCTL_OFF + 1024);
    const int TAIL0 = ((M / 256) * (2 * FF / 256)) % G;
    bf16* H16 = XN;
    STAMP(40);
    if (HAS(12) && IN(0)) { const int lane = tid0 & 63, wave = __builtin_amdgcn_readfirstlane(tid0 >> 6); for (int dup = 0; dup < DUPN(0); ++dup) conv_phase(args, lds, 0, 0, vcu * NWAVES + wave, NGW, lane, wave);
        for (int dup = 0; dup < DUPN(1); ++dup) cast_phase(args.in[I_X], H16, SSQ, vcu * NWAVES + wave, NGW, lane); }
    STAMP(42);
    SEAM(0);
    STAMP(41);
    for (int l = 0; l < NLAYER; ++l) {
        const int pb = 1 + 9 * l;
        const int wave = wave_s;
        unsigned char* wl = ws + WS_W + (size_t)l * LW_SIZE;
        float* ssq0 = SSQ + (size_t)(l * 3 + 0) * M * 64; float* ssq1 = SSQ + (size_t)(l * 3 + 1) * M * 64; float* ssq2 = SSQ + (size_t)(l * 3 + 2) * M * 64; float* ssq0n = SSQ + (size_t)(l * 3 + 3) * M * 64;
        STAMP(16 * l + 9);
        if (HAS(0) && IN(pb + 0)) { pg8::Gemm g{H16, (const bf16*)(wl + LW_FI0), M, 2 * FF, D}; pg8::StaticOrder S; S.init(M, 2 * FF, G, bx, WGM_WIDE);
            { MK_TID(t0); pg8::row_scales_phase(ssq0, 1.0f / D, EPS, RSL, PM0, t0); } pg8::EpiSwiglu E{HID, FF, ssq0, 1.0f / D, EPS, RSL, PM0};
            if (DUPN(2) == 2 && PROBE_NULL) { pg8::EpiNull E0{HID}; pg8::gemm_phase<pg8::EpiNull, pg8::StaticOrder, true, PG8_SP2>(lds, g, S, E0, wave_s); } else if (DUPN(2) == 2) { pg8::gemm_phase<pg8::EpiSwiglu, pg8::StaticOrder, true, PG8_SP2>(lds, g, S, E, wave_s); }
            pg8::gemm_phase<pg8::EpiSwiglu, pg8::StaticOrder, true, PG8_SP2>(lds, g, S, E, wave_s);
            STAMP(16 * l + 46);
            if (bx >= TAIL0) { MK_TID(t1); conv_phase(args, lds, 1, l, (bx - TAIL0) * NWAVES + wave, (G - TAIL0) * NWAVES, t1 & 63, wave); } }
        STAMP(16 * l + 44);
        SEAM(pb + 0);
        STAMP(16 * l + 10);
        if (HAS(1) && IN(pb + 1)) { pg8::Gemm g{HID, (const bf16*)(wl + LW_FO0), M, D, FF}; pg8::StaticOrder S; S.init(M, D, G, bx, WGM_FFNOUT);
            if (DUPN(3) == 2 && PROBE_NULL) { pg8::EpiNull E0{HID}; pg8::gemm_phase<pg8::EpiNull, pg8::StaticOrder, true, PG8_SP2>(lds, g, S, E0, wave_s); }
            else if (DUPN(3) == 2) { pg8::EpiResid<false, false> E2{H16, YCAT, D, 0.5f, ssq1}; pg8::gemm_phase<pg8::EpiResid<false, false>, pg8::StaticOrder, true, PG8_SP2>(lds, g, S, E2, wave_s); }
            if (l == 0) { pg8::EpiResid<true, false> E{args.in[I_X], H16, D, 0.5f, ssq1}; pg8::gemm_phase<pg8::EpiResid<true, false>, pg8::StaticOrder, true, PG8_SP2>(lds, g, S, E, wave_s); }
            else { pg8::EpiResid<false, false> E{H16, H16, D, 0.5f, ssq1}; pg8::gemm_phase<pg8::EpiResid<false, false>, pg8::StaticOrder, true, PG8_SP2>(lds, g, S, E, wave_s); } }
        SEAM(pb + 1);
        STAMP(16 * l + 11);
        if (HAS(2) && IN(pb + 2)) { pg8::Gemm g{H16, (const bf16*)(wl + LW_MIX), M, NIN, D}; pg8::StaticOrder S; S.init(M, NIN, G, bx, WGM_WIDE); { MK_TID(t2); pg8::row_scales_phase(ssq1, 1.0f / D, EPS, RSL, PM0, t2); } pg8::EpiMix E{MIXO, NIN, C_G / 256, ssq1, 1.0f / D, EPS, RSL, PM0, args.in[I_QG] + l * 64, args.in[I_KG] + l * 64, (LAS float*)(lds + QKX_OFF), C_DQ / 256, C_DK / 256, C_DV / 256};
            for (int dup = 0; dup < DUPN(4); ++dup) { pg8::gemm_phase<pg8::EpiMix, pg8::StaticOrder, true, PG8_SP2>(lds, g, S, E, wave_s); } }
        STAMP(16 * l + 47);
        SEAM(pb + 2);
        if (HAS(3) && IN(pb + 3)) {
            MK_TID(t3); const int lane = t3 & 63;
            STAMP(16 * l + 0);
            if (HAS(13)) for (int dup = 0; dup < DUPN(5); ++dup) ssm_phase(args, l, lds, lane, wave, bx, G);
            STAMP(16 * l + 1);
            asm volatile("s_waitcnt vmcnt(0)" ::: "memory"); __syncthreads();
            { MK_TID(ts); if (ts == 0 && bx < NB * 64) { __builtin_amdgcn_fence(__ATOMIC_RELEASE, "agent"); asm volatile("s_waitcnt vmcnt(0)" ::: "memory");
                (void)__hip_atomic_fetch_add(ctl + CW_SSMF + 64 * l, (unsigned)((NB * 64 - bx + G - 1) / G), __ATOMIC_RELAXED, __HIP_MEMORY_SCOPE_AGENT); } }
            { const int jw = bx >> 3; if (G == 256 && jw < 24 && jw % 3 == 0) {
                MK_TID(tc); __syncthreads(); conv_range(args, l == 0 ? CVR_T0_LO : CVR_T1_LO, l == 0 ? CVR_T0_HI : CVR_T1_HI, (LAS float*)(lds + wave * 16384), ((jw / 3) * 8 + (bx & 7)) * NWAVES + wave, 64 * NWAVES, tc & 63); __syncthreads(); } }
            STAMP(16 * l + 2); STAMP(16 * l + 3); }
        if (IN(pb + 3) && !IN(pb + 4)) { }
        STAMP(16 * l + 4);
        if (HAS(4) && IN(pb + 4)) { { MK_TID(tr); ret_state_phase(args, l, lds, tr, tr & 63, wave); }
            { MK_TID(ta); if (HAS(13)) for (int dup = 0; dup < DUPN(7); ++dup) attn_phase(args, l, lds, ta, ta & 63, wave); }
            __syncthreads(); STAMP(16 * l + 5); { MK_TID(tb); ret_state_wait(args, l, tb); if (HAS(14)) for (int dup = 0; dup < DUPN(8); ++dup) ret_out_phase(args, lds, tb, tb & 63, wave); } __syncthreads(); STAMP(16 * l + 6);
            { MK_TID(tg); if (tg == 0) { XB_SPIN(xb_ld(ctl + CW_SSMF + 64 * l) < (unsigned)(NB * 64), ctl + CW_BAR); __builtin_amdgcn_fence(__ATOMIC_ACQUIRE, "agent"); asm volatile("s_waitcnt vmcnt(0)" ::: "memory"); } __syncthreads(); }
            if (HAS(15)) { pg8::Gemm g{YPRE, (const bf16*)(wl + LW_GLU), M, 1024, 1024}; pg8::StaticOrder S; S.init(M, 1024, G, bx); pg8::EpiGlu E{YPRE, 1024, YCAT, D, args.in[I_GLUB] + (size_t)l * 1024};
            for (int dup = 0; dup < DUPN(9); ++dup) { pg8::gemm_phase<pg8::EpiGlu, pg8::StaticOrder, true, PG8_SP2>(lds, g, S, E, wave_s); } } }
        STAMP(16 * l + 7);
        SEAM(pb + 4);
        STAMP(16 * l + 8);
#if defined(PROBE_ATTN2)
        if (IN(pb + 5)) { MK_TID(tz); attn_phase(args, l, lds, tz, tz & 63, wave); __syncthreads(); }
#endif
        if (HAS(5) && IN(pb + 5)) { pg8::Gemm g{YCAT, (const bf16*)(wl + LW_BR), M, D, D}; pg8::StaticOrder S; S.init(M, D, G, bx, WGM_SQ); pg8::EpiBranch E{MIXO + C_G, NIN, MERGED, D};
            for (int dup = 0; dup < DUPN(10); ++dup) { pg8::gemm_phase<pg8::EpiBranch, pg8::StaticOrder, true, PG8_SP2>(lds, g, S, E, wave_s); } }
        SEAM(pb + 5);
        STAMP(16 * l + 13);
        if (HAS(6) && IN(pb + 6)) { pg8::Gemm g{MERGED, (const bf16*)(wl + LW_OUT), M, D, D}; pg8::StaticOrder S; S.init(M, D, G, bx, WGM_SQ); pg8::EpiResid<false, false> E{H16, H16, D, 1.0f, ssq2};
            pg8::gemm_phase<pg8::EpiResid<false, false>, pg8::StaticOrder, true, PG8_SP2>(lds, g, S, E, wave_s); }
        SEAM(pb + 6);
        STAMP(16 * l + 14);
        if (HAS(7) && IN(pb + 7)) { pg8::Gemm g{H16, (const bf16*)(wl + LW_FI1), M, 2 * FF, D}; pg8::StaticOrder S; S.init(M, 2 * FF, G, bx, WGM_WIDE); { MK_TID(t7); pg8::row_scales_phase(ssq2, 1.0f / D, EPS, RSL, PM0, t7); } pg8::EpiSwiglu E{HID, FF, ssq2, 1.0f / D, EPS, RSL, PM0};
            if (DUPN(2) == 2 && PROBE_NULL) { pg8::EpiNull E0{HID}; pg8::gemm_phase<pg8::EpiNull, pg8::StaticOrder, true, PG8_SP2>(lds, g, S, E0, wave_s); } else if (DUPN(2) == 2) { pg8::gemm_phase<pg8::EpiSwiglu, pg8::StaticOrder, true, PG8_SP2>(lds, g, S, E, wave_s); }
            pg8::gemm_phase<pg8::EpiSwiglu, pg8::StaticOrder, true, PG8_SP2>(lds, g, S, E, wave_s);
            if (bx >= TAIL0) { MK_TID(t8); conv_phase(args, lds, 2, l, (bx - TAIL0) * NWAVES + wave, (G - TAIL0) * NWAVES, t8 & 63, wave); } }
        STAMP(16 * l + 45);
        SEAM(pb + 7);
        STAMP(16 * l + 15);
        if (HAS(8) && IN(pb + 8)) { pg8::Gemm g{HID, (const bf16*)(wl + LW_FO1), M, D, FF}; pg8::StaticOrder S; S.init(M, D, G, bx, WGM_FFNOUT);
            if (DUPN(3) == 2 && PROBE_NULL) { pg8::EpiNull E0{HID}; pg8::gemm_phase<pg8::EpiNull, pg8::StaticOrder, true, PG8_SP2>(lds, g, S, E0, wave_s); }
            else if (DUPN(3) == 2) { pg8::EpiResid<false, false> E2{H16, YCAT, D, 0.5f, ssq0n}; pg8::gemm_phase<pg8::EpiResid<false, false>, pg8::StaticOrder, true, PG8_SP2>(lds, g, S, E2, wave_s); }
            if (l + 1 < NLAYER) { pg8::EpiResid<false, false> E{H16, H16, D, 0.5f, ssq0n}; pg8::gemm_phase<pg8::EpiResid<false, false>, pg8::StaticOrder, true, PG8_SP2>(lds, g, S, E, wave_s); }
            else { pg8::EpiResid<false, true> E{H16, args.out, D, 0.5f, nullptr}; pg8::gemm_phase<pg8::EpiResid<false, true>, pg8::StaticOrder, true, PG8_SP2>(lds, g, S, E, wave_s); } }
        SEAM(pb + 8);
        STAMP(16 * l + 12);
    }
#if defined(PROBE_CLK)
    if (bx == 0 && hi - lo > 1) { __syncthreads(); if (wave_s == 0) { MK_TID(te_); if (te_ == 0) {
        const unsigned long long dc_ = (unsigned long long)__builtin_amdgcn_s_memtime() - __hip_atomic_load((unsigned long long*)(args.ws + WS_CTL + 524288) + 100, __ATOMIC_RELAXED, __HIP_MEMORY_SCOPE_AGENT);
        const unsigned long long t0_ = __builtin_amdgcn_s_memrealtime(); while (__builtin_amdgcn_s_memrealtime() - t0_ < dc_ / 64) __builtin_amdgcn_s_sleep(8); } } __syncthreads(); }
#endif
#if defined(PROBE_CLK)
    if (bx == 0 && hi - lo > 1) { __syncthreads(); if (wave_s == 0) { MK_TID(te_); if (te_ == 0) {
        const unsigned long long dc_ = (unsigned long long)__builtin_amdgcn_s_memtime() - __hip_atomic_load((unsigned long long*)(args.ws + WS_CTL + 524288) + 100, __ATOMIC_RELAXED, __HIP_MEMORY_SCOPE_AGENT);
        const unsigned long long t0_ = __builtin_amdgcn_s_memrealtime(); while (__builtin_amdgcn_s_memrealtime() - t0_ < dc_ / 64) __builtin_amdgcn_s_sleep(8); } } __syncthreads(); }
#endif
#if defined(PROBE_AMP)
    if (hi - lo > 1 && bx == ((PROBE_WG) >= 0 ? (PROBE_WG) : 0)) { __syncthreads(); if (wave_s == 0) { MK_TID(te_);
        unsigned long long* sp_ = (unsigned long long*)(args.ws + WS_CTL + 524288); unsigned long long wait_ = 0;
        if ((PROBE_WG) >= 0) { for (int l = 0; l < NLAYER; ++l) wait_ += __hip_atomic_load(sp_ + bx * 64 + 16 * l + (PROBE_B), __ATOMIC_RELAXED, __HIP_MEMORY_SCOPE_AGENT) - __hip_atomic_load(sp_ + bx * 64 + 16 * l + (PROBE_A), __ATOMIC_RELAXED, __HIP_MEMORY_SCOPE_AGENT);
            wait_ *= (PROBE_AMP); }
        else { for (int l = ((PROBE_WG) == -3 ? (PROBE_A) : 0); l < (((PROBE_WG) == -2) ? 1 : ((PROBE_WG) == -3) ? (PROBE_A) + 1 : NLAYER); ++l) { const unsigned long long base_ = __hip_atomic_load(sp_ + 16 * l + (PROBE_B), __ATOMIC_RELAXED, __HIP_MEMORY_SCOPE_AGENT);
                int mx_ = -(1 << 30), sm_ = 0, am_ = 0;
                for (int k = 0; k < 4; ++k) { const int w_ = ((PROBE_WG) == -4) ? ((te_ * 4 + k) * 8 + (PROBE_A)) : te_ * 4 + k; const int r_ = (w_ < G) ? (int)(long long)(__hip_atomic_load(sp_ + w_ * 64 + 16 * l + (PROBE_B), __ATOMIC_RELAXED, __HIP_MEMORY_SCOPE_AGENT) - base_) : -(1 << 30);
                    if (w_ < G) sm_ += r_; if (r_ > mx_) { mx_ = r_; am_ = w_; } }
                for (int o = 1; o < 64; o <<= 1) { const int m2 = __shfl_xor(mx_, o), a2 = __shfl_xor(am_, o); sm_ += __shfl_xor(sm_, o); if (m2 > mx_ || (m2 == mx_ && a2 < am_)) { mx_ = m2; am_ = a2; } }
                if ((PROBE_WG) == -2) wait_ += (unsigned long long)am_ * 2000ull; else if ((PROBE_WG) == -3) wait_ += (unsigned long long)(am_ & 7) * 10000ull + 5000ull; else if ((PROBE_WG) == -4) wait_ += (unsigned long long)(PROBE_AMP) * (unsigned long long)(mx_ - sm_ / (G / 8)); else wait_ += (unsigned long long)(PROBE_AMP) * (unsigned long long)(mx_ - sm_ / G); } }
        if (te_ == 0) { const unsigned long long t0_ = __builtin_amdgcn_s_memrealtime(); while (__builtin_amdgcn_s_memrealtime() - t0_ < wait_) __builtin_amdgcn_s_sleep(8); } } __syncthreads(); }
#endif
#undef IN
#undef SEAM
}

extern "C" void kernel_launch(void* const* d_in, const int* in_sizes, int n_in, void* d_out, int out_size, void* d_ws, size_t ws_size, hipStream_t stream) {
    static int grid = 0;
    if (grid == 0) {
        if (n_in != 26 || in_sizes[0] != M * D || out_size != M * D || ws_size < WS_END) { fprintf(stderr, "kernel_launch: unexpected shapes (n_in %d, in0 %d, out %d, ws %zu < %zu); nothing launched\n", n_in, n_in > 0 ? in_sizes[0] : -1, out_size, ws_size, (size_t)WS_END); grid = -1; return; }
        int dev = 0, cus = 0, per_cu = 0;
        if (hipGetDevice(&dev) != hipSuccess || hipDeviceGetAttribute(&cus, hipDeviceAttributeMultiprocessorCount, dev) != hipSuccess) { grid = -1; return; }
        if (hipFuncSetAttribute((const void*)fwd_kernel, hipFuncAttributeMaxDynamicSharedMemorySize, LDS_BYTES) != hipSuccess) { fprintf(stderr, "kernel_launch: hipFuncSetAttribute failed\n"); grid = -1; return; }
        if (hipOccupancyMaxActiveBlocksPerMultiprocessor(&per_cu, (const void*)fwd_kernel, NWAVES * 64, LDS_BYTES) != hipSuccess || per_cu < 1) { fprintf(stderr, "kernel_launch: occupancy query says %d workgroups per CU\n", per_cu); }
        (void)hipGetLastError();
        grid = cus;
        if (grid % 8 != 0) { fprintf(stderr, "kernel_launch: %d CUs: this kernel's unit order needs a multiple of 8 workgroups; nothing launched\n", grid); grid = -1; return; }
    }
    if (grid < 0) return;
    if (hipMemsetAsync((char*)d_ws + WS_CTL, 0, CTL_ZERO_BYTES, stream) != hipSuccess) return;
    Args a{};
    for (int i = 0; i < 26; ++i) a.in[i] = (const float*)d_in[i];
    a.out = (float*)d_out; a.ws = (unsigned char*)d_ws;
#if MK_ONE_LAUNCH
    a.ph_lo = 0; a.ph_hi = N_PHASES;
    hipLaunchKernelGGL(fwd_kernel, dim3(grid), dim3(NWAVES * 64), LDS_BYTES, stream, a);
#else
    for (int p = 0; p < N_PHASES; ++p) { a.ph_lo = p; a.ph_hi = p + 1; hipLaunchKernelGGL(fwd_kernel, dim3(grid), dim3(NWAVES * 64), LDS_BYTES, stream, a); }
#endif
}
```
